# Optimizing an MI355X kernel written in HIP

```python
import jax, jax.numpy as jnp
from jax import lax
import numpy as np

D_MODEL = 1024
BATCH = 4
SEQ = 8192
DEPTH = 2

CHUNK = 64
Q_BLOCK = 128
NORM_EPS = 1e-6

SB_HEADS = 8
SB_HEAD_DIM = 64
SB_WIDTH = SB_HEADS * SB_HEAD_DIM
POOL_WINDOWS = (2, 4, 8, 16)
POOL_GROUPS = len(POOL_WINDOWS)
POOL_WIDTH = D_MODEL - SB_WIDTH
POOL_GROUP_DIM = POOL_WIDTH // POOL_GROUPS
EVEN_IN_WIDTH = 3 * SB_WIDTH + POOL_WIDTH
EVEN_MIX_WIDTH = SB_WIDTH + POOL_WIDTH

GLA_HEADS = 4
GLA_KEY_WIDTH = D_MODEL // 2
GLA_VALUE_WIDTH = D_MODEL
GLA_KEY_DIM = GLA_KEY_WIDTH // GLA_HEADS
GLA_VALUE_DIM = GLA_VALUE_WIDTH // GLA_HEADS
GLA_GATE_RANK = 16
GLA_TAU = 16.0
ODD_IN_WIDTH = 2 * GLA_KEY_WIDTH + 2 * GLA_VALUE_WIDTH + GLA_GATE_RANK

FFN_HIDDEN = 2816
CONV_WIDTH = 3

N_EVEN = (DEPTH + 1) // 2
N_ODD = DEPTH // 2

kernel_name = "hybrid_stickbreak_pool_gla_convffn"


def rms_norm(x, gain):
    xf = x.astype(jnp.float32)
    y = xf * lax.rsqrt(jnp.mean(xf * xf, axis=-1, keepdims=True) + NORM_EPS)
    return (y * gain.astype(jnp.float32)).astype(x.dtype)


def stick_breaking_attention(q, k, v):
    b, s, h, dh = q.shape
    qh = jnp.transpose(q, (0, 2, 1, 3))
    kh = jnp.transpose(k, (0, 2, 1, 3))
    vh = jnp.transpose(v, (0, 2, 1, 3))
    scale = dh ** -0.5
    key_pos = jnp.arange(s)

    def block(i):
        start = i * Q_BLOCK
        q_blk = lax.dynamic_slice_in_dim(qh, start, Q_BLOCK, axis=2)
        z = jnp.einsum('bhqd,bhkd->bhqk', q_blk, kh,
                       preferred_element_type=jnp.float32) * scale
        q_pos = start + jnp.arange(Q_BLOCK)
        visible = key_pos[None, :] < q_pos[:, None]
        log_fail = jnp.where(visible, jax.nn.log_sigmoid(-z), 0.0)
        cum_rev = lax.cumsum(log_fail, axis=3, reverse=True)
        later = jnp.concatenate([cum_rev[..., 1:], jnp.zeros_like(cum_rev[..., :1])], axis=-1)
        weights = jnp.where(visible, jnp.exp(jax.nn.log_sigmoid(z) + later), 0.0)
        return jnp.einsum('bhqk,bhkd->bhqd', weights.astype(vh.dtype), vh)

    out = lax.map(block, jnp.arange(s // Q_BLOCK))
    return jnp.transpose(out, (1, 0, 3, 2, 4)).reshape(b, s, h * dh)


def multiscale_pool(xb, pool_w, pool_scale):
    b, s, _ = xb.shape
    groups = xb.reshape(b, s, POOL_GROUPS, POOL_GROUP_DIM)
    prefix = jnp.cumsum(groups.astype(jnp.float32), axis=1)
    prefix = jnp.pad(prefix, ((0, 0), (1, 0), (0, 0), (0, 0)))
    pos = jnp.arange(1, s + 1, dtype=jnp.float32)
    outs = []
    for g, w in enumerate(POOL_WINDOWS):
        pg = jnp.pad(prefix[:, :, g], ((0, 0), (w - 1, 0), (0, 0)))
        window_sum = pg[:, w:] - pg[:, :s]
        count = jnp.minimum(pos, float(w))[None, :, None]
        pooled = window_sum / count - groups[:, :, g].astype(jnp.float32)
        outs.append(jnp.einsum('bsc,cd->bsd', pooled.astype(xb.dtype), pool_w[g]))
    return jnp.concatenate(outs, axis=-1) * pool_scale


def gated_linear_attention(q, k, v, log_alpha):
    b, s, h, dk = q.shape
    dv = v.shape[-1]
    n = s // CHUNK

    def chunks(t):
        return jnp.moveaxis(t.reshape(b, n, CHUNK, h, t.shape[-1]), 1, 0)

    qc = chunks(q.astype(jnp.float32))
    kc = chunks(k.astype(jnp.float32))
    vc = chunks(v.astype(jnp.float32))
    cum = jnp.cumsum(chunks(log_alpha), axis=2)
    total = cum[:, :, -1]
    k_dec = kc * jnp.exp(total[:, :, None] - cum)
    chunk_decay = jnp.exp(total)

    def step(state, inp):
        q_c, k_c, v_c, decay_c = inp
        state = decay_c[..., None] * state + jnp.einsum('bchk,bchv->bhkv', k_c, v_c)
        return state, jnp.einsum('bchk,bhkv->bchv', q_c, state)

    state0 = jnp.zeros((b, h, dk, dv), jnp.float32)
    _, out = lax.scan(step, state0, (qc, k_dec, vc, chunk_decay))
    return jnp.moveaxis(out, 0, 1).reshape(b, s, h, dv)


def even_mixer(h, w_in, q_gain, k_gain, pool_w, pool_scale, w_out):
    b, s, _ = h.shape
    proj = h @ w_in
    q, k, v, xb = jnp.split(proj, [SB_WIDTH, 2 * SB_WIDTH, 3 * SB_WIDTH], axis=-1)
    q = rms_norm(q.reshape(b, s, SB_HEADS, SB_HEAD_DIM), q_gain)
    k = rms_norm(k.reshape(b, s, SB_HEADS, SB_HEAD_DIM), k_gain)
    v = v.reshape(b, s, SB_HEADS, SB_HEAD_DIM)
    o_a = stick_breaking_attention(q, k, v)
    o_b = multiscale_pool(xb, pool_w, pool_scale)
    return jnp.concatenate([o_a.astype(h.dtype), o_b.astype(h.dtype)], axis=-1) @ w_out


def odd_mixer(h, w_in, w_a2, b_a, o_gain, w_out):
    b, s, _ = h.shape
    proj = h @ w_in
    q, k, v, r, a_low = jnp.split(
        proj, [GLA_KEY_WIDTH, 2 * GLA_KEY_WIDTH, 2 * GLA_KEY_WIDTH + GLA_VALUE_WIDTH,
               2 * GLA_KEY_WIDTH + 2 * GLA_VALUE_WIDTH], axis=-1)
    q = q.reshape(b, s, GLA_HEADS, GLA_KEY_DIM) * (GLA_KEY_DIM ** -0.5)
    k = k.reshape(b, s, GLA_HEADS, GLA_KEY_DIM)
    v = v.reshape(b, s, GLA_HEADS, GLA_VALUE_DIM)
    gate_logit = (a_low @ w_a2 + b_a).astype(jnp.float32).reshape(b, s, GLA_HEADS, GLA_KEY_DIM)
    log_alpha = jax.nn.log_sigmoid(gate_logit) / GLA_TAU
    o = gated_linear_attention(q, k, v, log_alpha)
    o = rms_norm(o, o_gain).reshape(b, s, GLA_VALUE_WIDTH).astype(h.dtype)
    return (o * jax.nn.silu(r)) @ w_out


def conv_ffn(h, w_up, conv_w, conv_b, w_down):
    s = h.shape[1]
    u = h @ w_up
    up = jnp.pad(u, ((0, 0), (CONV_WIDTH - 1, 0), (0, 0)))
    conv = conv_b
    for j in range(CONV_WIDTH):
        conv = conv + conv_w[j] * up[:, j:j + s]
    a, g = jnp.split(conv, 2, axis=-1)
    return (jax.nn.silu(a) * g) @ w_down


def setup_inputs(seed: int = 0) -> dict:
    key = jax.random.key(seed)
    ks = jax.random.split(key, 20)
    f32 = jnp.float32

    def nrm(k, shape, scale):
        return jax.random.normal(k, shape, f32) * scale

    return {
        "x": nrm(ks[0], (BATCH, SEQ, D_MODEL), 1.0),
        "mix_norm_even": 1.0 + nrm(ks[1], (N_EVEN, D_MODEL), 0.02),
        "w_in_even": nrm(ks[2], (N_EVEN, D_MODEL, EVEN_IN_WIDTH), D_MODEL ** -0.5),
        "sb_q_gain": 1.0 + nrm(ks[3], (N_EVEN, SB_HEAD_DIM), 0.02),
        "sb_k_gain": 1.0 + nrm(ks[4], (N_EVEN, SB_HEAD_DIM), 0.02),
        "pool_w": nrm(ks[5], (N_EVEN, POOL_GROUPS, POOL_GROUP_DIM, POOL_GROUP_DIM), POOL_GROUP_DIM ** -0.5),
        "pool_scale": 1.0 + nrm(ks[6], (N_EVEN, POOL_WIDTH), 0.1),
        "w_out_even": nrm(ks[7], (N_EVEN, EVEN_MIX_WIDTH, D_MODEL), EVEN_MIX_WIDTH ** -0.5),
        "mix_norm_odd": 1.0 + nrm(ks[8], (N_ODD, D_MODEL), 0.02),
        "w_in_odd": nrm(ks[9], (N_ODD, D_MODEL, ODD_IN_WIDTH), D_MODEL ** -0.5),
        "gla_w_a2": nrm(ks[10], (N_ODD, GLA_GATE_RANK, GLA_KEY_WIDTH), GLA_GATE_RANK ** -0.5),
        "gla_b_a": nrm(ks[11], (N_ODD, GLA_KEY_WIDTH), 0.01),
        "gla_o_gain": 1.0 + nrm(ks[12], (N_ODD, GLA_VALUE_DIM), 0.02),
        "w_out_odd": nrm(ks[13], (N_ODD, GLA_VALUE_WIDTH, D_MODEL), GLA_VALUE_WIDTH ** -0.5),
        "ffn_norm": 1.0 + nrm(ks[14], (DEPTH, D_MODEL), 0.02),
        "ffn_w_up": nrm(ks[15], (DEPTH, D_MODEL, 2 * FFN_HIDDEN), D_MODEL ** -0.5),
        "ffn_conv_w": nrm(ks[16], (DEPTH, CONV_WIDTH, 2 * FFN_HIDDEN), CONV_WIDTH ** -0.5),
        "ffn_conv_b": nrm(ks[17], (DEPTH, 2 * FFN_HIDDEN), 0.01),
        "ffn_w_down": nrm(ks[18], (DEPTH, FFN_HIDDEN, D_MODEL), FFN_HIDDEN ** -0.5),
    }


def reference(x, mix_norm_even, w_in_even, sb_q_gain, sb_k_gain, pool_w, pool_scale, w_out_even,
              mix_norm_odd, w_in_odd, gla_w_a2, gla_b_a, gla_o_gain, w_out_odd,
              ffn_norm, ffn_w_up, ffn_conv_w, ffn_conv_b, ffn_w_down):
    for layer in range(DEPTH):
        if layer % 2 == 0:
            i = layer // 2
            x = x + even_mixer(rms_norm(x, mix_norm_even[i]), w_in_even[i], sb_q_gain[i],
                               sb_k_gain[i], pool_w[i], pool_scale[i], w_out_even[i])
        else:
            i = layer // 2
            x = x + odd_mixer(rms_norm(x, mix_norm_odd[i]), w_in_odd[i], gla_w_a2[i],
                              gla_b_a[i], gla_o_gain[i], w_out_odd[i])
        x = x + conv_ffn(rms_norm(x, ffn_norm[layer]), ffn_w_up[layer], ffn_conv_w[layer],
                         ffn_conv_b[layer], ffn_w_down[layer])
    return x
```

```cpp
#include <hip/hip_runtime.h>
#include <hip/hip_cooperative_groups.h>
#include <cstdio>
#include <cstdint>
namespace cg = cooperative_groups;

#ifndef MK_SINGLE
#define MK_SINGLE 1
#endif

#define LAS __attribute__((address_space(3)))
typedef unsigned short bf16_t;
typedef short bf16x8 __attribute__((ext_vector_type(8)));
typedef float f32x4 __attribute__((ext_vector_type(4)));
typedef float f32x16 __attribute__((ext_vector_type(16)));
typedef unsigned u32x4 __attribute__((ext_vector_type(4)));
typedef unsigned u32x2 __attribute__((ext_vector_type(2)));

constexpr int DM = 1024, NB = 4, SEQ = 8192, M = NB * SEQ;
constexpr int FF = 2816, FF2 = 5632;
constexpr float EPS = 1e-6f;
constexpr float LOG2E = 1.4426950408889634f, LN2 = 0.6931471805599453f;

typedef float f32x2_t __attribute__((ext_vector_type(2))); typedef __bf16 bf16x2_t __attribute__((ext_vector_type(2)));
__device__ __forceinline__ unsigned cvt_pk_bf16(float lo, float hi) { f32x2_t v = {lo, hi}; bf16x2_t b = __builtin_convertvector(v, bf16x2_t); return __builtin_bit_cast(unsigned, b); }
__device__ __forceinline__ unsigned f2bf(float f) { unsigned u = __builtin_bit_cast(unsigned, f); return (u + 0x7fffu + ((u >> 16) & 1u)) >> 16; }
__device__ __forceinline__ float bf2f(unsigned short h) { return __builtin_bit_cast(float, (unsigned)h << 16); }
__device__ __forceinline__ u32x4 pack8(f32x4 a, f32x4 b) { u32x4 w; w.x = cvt_pk_bf16(a[0], a[1]); w.y = cvt_pk_bf16(a[2], a[3]); w.z = cvt_pk_bf16(b[0], b[1]); w.w = cvt_pk_bf16(b[2], b[3]); return w; }
__device__ __forceinline__ float row_rstd(const float* ssq, int row) {
    const f32x4* p = (const f32x4*)(ssq + (size_t)row * 16);
    const f32x4 a = p[0], b = p[1], c = p[2], d = p[3];
    const float s = ((a[0] + a[1]) + (a[2] + a[3])) + ((b[0] + b[1]) + (b[2] + b[3])) + ((c[0] + c[1]) + (c[2] + c[3])) + ((d[0] + d[1]) + (d[2] + d[3]));
    return rsqrtf(s * (1.0f / 1024.0f) + EPS);
}
template <int CTRL> __device__ __forceinline__ float dpp0(float v) {
    return __builtin_bit_cast(float, __builtin_amdgcn_update_dpp(0, __builtin_bit_cast(int, v), CTRL, 0xf, 0xf, true));
}

namespace pg8 {
constexpr int BM = 256, BK = 64, HALF = 128, HTB = HALF * BK * 2, STAGE_BYTES = 8 * HTB, NXCD = 8, WGM = 8;
__host__ __device__ __forceinline__ int lds_byte(int r, int c) { const int st = (r >> 4) * 2 + (c >> 5), rr = r & 15, cc = c & 31, ob = rr * 64 + cc * 2; return st * 1024 + (ob ^ (((ob >> 9) & 1) << 5)); }
__host__ __device__ __forceinline__ void stage_rc(int b, int& R, int& C) { const int st = b / 1024, sb = b % 1024, swz = sb ^ (((sb >> 9) & 1) << 5); R = (st >> 1) * 16 + swz / 64; C = (st & 1) * 32 + (swz % 64) / 2; }
__host__ __device__ __forceinline__ int perm32(int rho) { const int n = rho >> 4, i = rho & 15; return 8 * (i >> 2) + 4 * n + (i & 3); }

struct Unit { int pm, pn, idx; };
__host__ __device__ __forceinline__ size_t bimg_off(int n, int k, int nkt) {
    const int n2 = n & 127, x = n2 & 31, rho = 16 * ((x >> 2) & 1) + 4 * (x >> 3) + (x & 3), R = (n2 & ~31) + rho;
    return ((size_t)((n >> 8) * nkt + (k >> 6)) * 2 + ((n >> 7) & 1)) * 8192 + (size_t)(lds_byte(R, k & 63) >> 1);
}
__host__ __device__ __forceinline__ size_t aimg_off(int row, int col, int nkt) {
    return ((size_t)((row >> 8) * nkt + (col >> 6)) * 2 + ((row >> 7) & 1)) * 8192 + (size_t)(lds_byte(row & 127, col & 63) >> 1);
}
struct Gemm { const bf16_t* A; const bf16_t* Bt; int lda, ldb, K, a_pn_off, nM, nN; };

struct StaticOrder {
    int nM, nN, nwg, G, c;
    __device__ __forceinline__ void init(int nM_, int nN_, int G_, int c_) { nM = nM_; nN = nN_; nwg = nM * nN; G = G_; c = c_; }
    __device__ __forceinline__ bool next(int i, Unit& u) const {
        const long L = (long)i * G + c; if (L >= nwg) return false;
        int wgid = (int)L; { const int q = nwg / NXCD, r = nwg % NXCD, xcd = wgid % NXCD, off = wgid / NXCD; wgid = (xcd < r ? xcd * (q + 1) : r * (q + 1) + (xcd - r) * q) + off; }
        const int nig = WGM * nN, gid = wgid / nig, fm = gid * WGM, gsz = (nM - fm) < WGM ? (nM - fm) : WGM;
        u.pm = fm + ((wgid % nig) % gsz); u.pn = (wgid % nig) / gsz; u.idx = i; return true;
    }
};

template <class Epi, bool HALO>
__device__ __forceinline__ void gemm_phase(LAS unsigned char* lds, const Gemm g, const StaticOrder& S, const Epi& E) {
    int tid = threadIdx.x; asm volatile("" : "+v"(tid));
    const int wid = __builtin_amdgcn_readfirstlane(tid >> 6), lane = tid & 63, wr = wid >> 2, wc = wid & 3, fr = lane & 15, fq = lane >> 4;
    const int K = g.K, nt = K / BK;
    unsigned voffA[2], voffB[2];
#pragma unroll
    for (int i = 0; i < 2; ++i) { int R, C; stage_rc(tid * 16 + i * 8192, R, C); const int Rb = (R & ~31) + perm32(R & 31);
        (void)Rb; voffA[i] = HALO ? (unsigned)(tid * 16 + i * 8192) : (unsigned)(R * g.lda + C) * 2u; voffB[i] = (unsigned)(tid * 16 + i * 8192); }
    const size_t kstep = HALO ? (size_t)2 * HTB : (size_t)(BK * 2), kstepB = (size_t)2 * HTB;
    const size_t hstepA = HALO ? (size_t)HTB : (size_t)128 * g.lda * 2, hstepB = (size_t)HTB;
    const size_t tstepA = HALO ? (size_t)nt * 2 * HTB : (size_t)256 * g.lda * 2, tstepB = (size_t)nt * 2 * HTB;
    const char* A0 = (const char*)g.A;
    const unsigned ldsw = (unsigned)wid * 1024u;
    const int aoff = lds_byte(wr * 64 + fr, fq * 8), boff = lds_byte(wc * 32 + fr, fq * 8);
#define PG8_SA(b, h) (((b) * 2 + (h)) * HTB)
#define PG8_SB(b, h) ((4 + (b) * 2 + (h)) * HTB)
#define PG8_STAGE(bufoff, gbase, voff) do { _Pragma("unroll") for (int _i = 0; _i < 2; ++_i) \
        __builtin_amdgcn_global_load_lds((const unsigned*)((const char*)(gbase) + (voff)[_i]), (LAS unsigned*)(lds + (bufoff) + ldsw + _i * 8192), 16, 0, 0); } while (0)
#define PG8_LDA(dst, b, h) do { _Pragma("unroll") for (int m = 0; m < 4; ++m) _Pragma("unroll") for (int k = 0; k < 2; ++k) dst[m][k] = *(const LAS bf16x8*)(lds + PG8_SA(b, h) + aoff + m * 2048 + k * 1024); } while (0)
#define PG8_LDB(dst, b, h) do { _Pragma("unroll") for (int n = 0; n < 2; ++n) _Pragma("unroll") for (int k = 0; k < 2; ++k) dst[n][k] = *(const LAS bf16x8*)(lds + PG8_SB(b, h) + boff + n * 2048 + k * 1024); } while (0)
#define PG8_MMA(ai, bj, At, Bt) do { __builtin_amdgcn_s_setprio(1); _Pragma("unroll") for (int m = 0; m < 4; ++m) _Pragma("unroll") for (int n = 0; n < 2; ++n) _Pragma("unroll") for (int k = 0; k < 2; ++k) \
        acc[ai][bj][m][n] = __builtin_amdgcn_mfma_f32_16x16x32_bf16(Bt[n][k], At[m][k], acc[ai][bj][m][n], 0, 0, 0); __builtin_amdgcn_s_setprio(0); } while (0)
#define PG8_WAIT_V(n) asm volatile("s_waitcnt vmcnt(" #n ")" ::: "memory")
#define PG8_WAIT_L(n) asm volatile("s_waitcnt lgkmcnt(" #n ")" ::: "memory")
#define PG8_BAR __builtin_amdgcn_s_barrier()
#define PG8_SCHED __builtin_amdgcn_sched_barrier(0)
    Unit cur, nxt; int ui = 0;
    if (!S.next(0, cur)) return;
    f32x4 acc[2][2][4][2];
#pragma unroll
    for (int a = 0; a < 2; ++a)
#pragma unroll
        for (int b = 0; b < 2; ++b)
#pragma unroll
            for (int m = 0; m < 4; ++m)
#pragma unroll
                for (int n = 0; n < 2; ++n) acc[a][b][m][n] = (f32x4){0.f, 0.f, 0.f, 0.f};
    bf16x8 At[4][2], B0[2][2], B1[2][2];
    const char* cA = A0 + (size_t)cur.pm * tstepA + (size_t)cur.pn * g.a_pn_off * 2; const char* cB = (const char*)g.Bt + (size_t)cur.pn * tstepB;
    PG8_STAGE(PG8_SB(0, 0), cB, voffB); PG8_STAGE(PG8_SB(0, 1), cB + hstepB, voffB); PG8_STAGE(PG8_SA(0, 0), cA, voffA); PG8_STAGE(PG8_SA(0, 1), cA + hstepA, voffA);
    if (wr == 1) PG8_BAR;
    PG8_WAIT_V(2); PG8_BAR;
    PG8_STAGE(PG8_SB(1, 0), cB + kstepB, voffB); PG8_STAGE(PG8_SA(1, 0), cA + kstep, voffA); PG8_STAGE(PG8_SB(1, 1), cB + hstepB + kstepB, voffB);
    PG8_WAIT_V(6); PG8_BAR;
    for (;;) {
        const bool has_next = S.next(ui + 1, nxt);
        const char* nA = has_next ? A0 + (size_t)nxt.pm * tstepA + (size_t)nxt.pn * g.a_pn_off * 2 : cA; const char* nB = has_next ? (const char*)g.Bt + (size_t)nxt.pn * tstepB : cB;
        for (int t = 0; t < nt; t += 2) {
            const bool last = (t == nt - 2);
            const char* a1 = cA + (size_t)(t + 1) * kstep;
            const char* a2 = last ? nA : cA + (size_t)(t + 2) * kstep; const char* b2 = last ? nB : cB + (size_t)(t + 2) * kstepB;
            const char* a3 = a2 + kstep; const char* b3 = b2 + kstepB;
            PG8_LDB(B0, 0, 0); PG8_LDB(B1, 0, 1); PG8_SCHED; PG8_LDA(At, 0, 0); PG8_STAGE(PG8_SA(1, 1), a1 + hstepA, voffA);
            PG8_WAIT_V(8); PG8_WAIT_L(0); PG8_BAR; PG8_MMA(0, 0, At, B0); PG8_MMA(0, 1, At, B1); PG8_BAR; PG8_SCHED;
            PG8_LDA(At, 0, 1); PG8_STAGE(PG8_SB(0, 0), b2, voffB); PG8_STAGE(PG8_SB(0, 1), b2 + hstepB, voffB); PG8_STAGE(PG8_SA(0, 0), a2, voffA);
            PG8_WAIT_V(8); PG8_WAIT_L(0); PG8_BAR; PG8_MMA(1, 0, At, B0); PG8_MMA(1, 1, At, B1); PG8_BAR; PG8_SCHED;
            PG8_LDB(B0, 1, 0); PG8_LDB(B1, 1, 1); PG8_SCHED; PG8_LDA(At, 1, 0); PG8_STAGE(PG8_SA(0, 1), a2 + hstepA, voffA);
            PG8_WAIT_V(8); PG8_WAIT_L(0); PG8_BAR; PG8_MMA(0, 0, At, B0); PG8_MMA(0, 1, At, B1); PG8_BAR; PG8_SCHED;
            PG8_LDA(At, 1, 1); PG8_STAGE(PG8_SB(1, 0), b3, voffB); PG8_STAGE(PG8_SB(1, 1), b3 + hstepB, voffB); PG8_STAGE(PG8_SA(1, 0), a3, voffA);
            PG8_WAIT_V(8); PG8_WAIT_L(0); PG8_BAR; PG8_MMA(1, 0, At, B0); PG8_MMA(1, 1, At, B1); PG8_BAR; PG8_SCHED;
        }
        if (wr == 0) PG8_BAR;
        { int l_ = threadIdx.x, wr_ = wr, wc_ = wc;
          asm volatile("" : "+v"(l_), "+s"(wr_), "+s"(wc_));
          E(acc, cur, wr_, wc_, l_ & 15, (l_ >> 4) & 3); }
        if (!has_next) break;
#pragma unroll
        for (int a = 0; a < 2; ++a)
#pragma unroll
            for (int b = 0; b < 2; ++b)
#pragma unroll
                for (int m = 0; m < 4; ++m)
#pragma unroll
                    for (int n = 0; n < 2; ++n) acc[a][b][m][n] = (f32x4){0.f, 0.f, 0.f, 0.f};
        cur = nxt; cA = nA; cB = nB; ++ui;
        if (wr == 1) PG8_BAR;
    }
    PG8_WAIT_V(0);
    PG8_BAR;
#undef PG8_SA
#undef PG8_SB
#undef PG8_STAGE
#undef PG8_LDA
#undef PG8_LDB
#undef PG8_MMA
#undef PG8_WAIT_V
#undef PG8_WAIT_L
#undef PG8_BAR
#undef PG8_SCHED
}
}
typedef f32x4 AccT[2][2][4][2];

struct EpiIn0 {
    const LAS float* rst; const float* qg; const float* kg; bf16_t* Q; bf16_t* Kb; bf16_t* VT; bf16_t* XP;
    __device__ __forceinline__ void operator()(const AccT& acc, const pg8::Unit& u, int wr, int wc, int fr, int fq) const {
        const int pn = u.pn;
        if (pn < 4) {
            const LAS float* gp = rst + 2816 + (pn < 2 ? 0 : 64);
            f32x4 gv[2][2];
#pragma unroll
            for (int bj = 0; bj < 2; ++bj)
#pragma unroll
                for (int n = 0; n < 2; ++n) gv[bj][n] = *(const LAS f32x4*)(gp + 32 * bj + 8 * fq + 4 * n);
            bf16_t* dst = (pn < 2 ? Q : Kb) + (size_t)((pn & 1) * 4 + wc) * 8192 * 64 + 8 * fq;
            const float sc = (pn < 2) ? 0.125f * LOG2E : 1.0f;
#pragma unroll
            for (int ai = 0; ai < 2; ++ai)
#pragma unroll
                for (int m = 0; m < 4; ++m) {
                    const int row = u.pm * 256 + ai * 128 + wr * 64 + m * 16 + fr;
                    const float rs = rst[u.idx * 256 + ai * 128 + wr * 64 + m * 16 + fr];
                    f32x4 v[2][2]; float ss = 0.f;
#pragma unroll
                    for (int bj = 0; bj < 2; ++bj)
#pragma unroll
                        for (int n = 0; n < 2; ++n) { v[bj][n] = acc[ai][bj][m][n] * rs; const f32x4 x = v[bj][n]; ss += (x[0] * x[0] + x[1] * x[1]) + (x[2] * x[2] + x[3] * x[3]); }
                    ss += __shfl_xor(ss, 16); ss += __shfl_xor(ss, 32);
                    const float r2 = rsqrtf(ss * (1.0f / 64.0f) + EPS) * sc;
#pragma unroll
                    for (int bj = 0; bj < 2; ++bj) {
                        const f32x4 a = v[bj][0] * r2 * gv[bj][0], b = v[bj][1] * r2 * gv[bj][1];
                        if (pn < 2) *(u32x4*)(dst + ((size_t)(row >> 13) * 8 * 8192 + (row & 8191)) * 64 + 32 * bj) = pack8(a, b);
                        else {
                            const int sq = row & 8191, kap_ = sq & 31, rho = (kap_ & 3) + 4 * (kap_ >> 4) + 8 * ((kap_ & 15) >> 2);
                            *(u32x4*)(Kb + ((((size_t)((row >> 13) * 8 + (pn & 1) * 4 + wc) * 256 + (sq >> 5)) * 4 + 2 * bj + (fq >> 1)) * 64 + (fq & 1) * 32 + rho) * 8) = pack8(a, b);
                        }
                    }
                }
        } else if (pn < 6) {
#pragma unroll
            for (int ai = 0; ai < 2; ++ai)
#pragma unroll
                for (int m = 0; m < 4; ++m) {
                    const int row = u.pm * 256 + ai * 128 + wr * 64 + m * 16 + fr;
                    const float rs = rst[u.idx * 256 + ai * 128 + wr * 64 + m * 16 + fr];
                    const int b = row >> 13, s = row & 8191, head = (pn - 4) * 4 + wc;
                    const int kap_ = s & 31;
                    bf16_t* vt = VT + ((((size_t)(b * 8 + head) * 256 + (s >> 5)) * 4 + ((kap_ >> 3) & 1)) * 64 + (kap_ >> 4) * 32 + 8 * fq) * 8 + (kap_ & 7);
#pragma unroll
                    for (int bj = 0; bj < 2; ++bj)
#pragma unroll
                        for (int n = 0; n < 2; ++n)
#pragma unroll
                            for (int e = 0; e < 4; ++e) vt[bj * 1024 + (4 * n + e) * 8] = (bf16_t)f2bf(acc[ai][bj][m][n][e] * rs);
                }
        } else {
            bf16_t* dst = XP + (pn - 6) * 256 + 64 * wc + 8 * fq;
#pragma unroll
            for (int ai = 0; ai < 2; ++ai)
#pragma unroll
                for (int m = 0; m < 4; ++m) {
                    const int row = u.pm * 256 + ai * 128 + wr * 64 + m * 16 + fr;
                    const float rs = rst[u.idx * 256 + ai * 128 + wr * 64 + m * 16 + fr];
#pragma unroll
                    for (int bj = 0; bj < 2; ++bj)
                        *(u32x4*)(dst + (size_t)row * 512 + 32 * bj) = pack8(acc[ai][bj][m][0] * rs, acc[ai][bj][m][1] * rs);
                }
        }
    }
};
struct EpiIn1 {
    const LAS float* rst; bf16_t* Q; bf16_t* Kb; bf16_t* VT; bf16_t* R;
    __device__ __forceinline__ void operator()(const AccT& acc, const pg8::Unit& u, int wr, int wc, int fr, int fq) const {
        const int pn = u.pn;
#pragma unroll
        for (int ai = 0; ai < 2; ++ai)
#pragma unroll
            for (int m = 0; m < 4; ++m) {
                const int row = u.pm * 256 + ai * 128 + wr * 64 + m * 16 + fr;
                const float rs = rst[u.idx * 256 + ai * 128 + wr * 64 + m * 16 + fr];
                if (pn < 4) {
                    const float sc = (pn < 2) ? rs * 0.08838834764831845f : rs;
                    if (pn < 2) {
                        const int sq = row & 8191;
                        bf16_t* dst = Q + (((((size_t)((row >> 13) * 4 + 2 * pn) * 128 + (sq >> 6)) * 4 + ((sq >> 4) & 3)) * 4 + wc) * 64 + fq * 16 + (sq & 15)) * 8;
#pragma unroll
                        for (int bj = 0; bj < 2; ++bj) *(u32x4*)(dst + (size_t)bj * 8192 * 128) = pack8(acc[ai][bj][m][0] * sc, acc[ai][bj][m][1] * sc);
                    } else {
                        bf16_t* dst = Kb + (size_t)row * 512 + (pn & 1) * 256 + 32 * wc + 8 * fq;
#pragma unroll
                        for (int bj = 0; bj < 2; ++bj) *(u32x4*)(dst + 128 * bj) = pack8(acc[ai][bj][m][0] * sc, acc[ai][bj][m][1] * sc);
                    }
                } else if (pn < 8) {
                    const int b = row >> 13, s = row & 8191, h = pn - 4;
                    bf16_t* vt = VT + (((((size_t)(b * 4 + h) * 128 + (s >> 6)) * 16 + 2 * wc + (fq >> 1)) * 2 + ((s >> 5) & 1)) * 64 + ((s >> 3) & 3) * 16 + 8 * (fq & 1)) * 8 + (s & 7);
#pragma unroll
                    for (int bj = 0; bj < 2; ++bj)
#pragma unroll
                        for (int n = 0; n < 2; ++n)
#pragma unroll
                            for (int e = 0; e < 4; ++e) vt[bj * 8192 + (4 * n + e) * 8] = (bf16_t)f2bf(acc[ai][bj][m][n][e] * rs);
                } else {
                    bf16_t* dst = R + (size_t)row * 1024 + (pn - 8) * 256 + 32 * wc + 8 * fq;
#pragma unroll
                    for (int bj = 0; bj < 2; ++bj) *(u32x4*)(dst + 128 * bj) = pack8(acc[ai][bj][m][0] * rs, acc[ai][bj][m][1] * rs);
                }
            }
    }
};
template <bool LAST>
struct EpiRes {
    bf16_t* XB; float* out; float* ssq_out;
    __device__ __forceinline__ void operator()(const AccT& acc, const pg8::Unit& u, int wr, int wc, int fr, int fq) const {
#pragma unroll
        for (int ai = 0; ai < 2; ++ai)
#pragma unroll
            for (int m = 0; m < 4; ++m) {
                const int row = u.pm * 256 + ai * 128 + wr * 64 + m * 16 + fr;
                const size_t off = (size_t)row * 1024 + u.pn * 256 + 32 * wc + 8 * fq;
                float ss = 0.f;
#pragma unroll
                for (int bj = 0; bj < 2; ++bj) {
                    const u32x4 bv = *(const u32x4*)(XB + off + 128 * bj);
                    f32x4 b0, b1;
                    b0[0] = __builtin_bit_cast(float, bv[0] << 16); b0[1] = __builtin_bit_cast(float, bv[0] & 0xffff0000u); b0[2] = __builtin_bit_cast(float, bv[1] << 16); b0[3] = __builtin_bit_cast(float, bv[1] & 0xffff0000u);
                    b1[0] = __builtin_bit_cast(float, bv[2] << 16); b1[1] = __builtin_bit_cast(float, bv[2] & 0xffff0000u); b1[2] = __builtin_bit_cast(float, bv[3] << 16); b1[3] = __builtin_bit_cast(float, bv[3] & 0xffff0000u);
                    const f32x4 o0 = b0 + acc[ai][bj][m][0], o1 = b1 + acc[ai][bj][m][1];
                    if (LAST) { *(f32x4*)(out + off + 128 * bj) = o0; *(f32x4*)(out + off + 128 * bj + 4) = o1; }
                    else {
                        *(u32x4*)(XB + off + 128 * bj) = pack8(o0, o1);
                        ss += ((o0[0] * o0[0] + o0[1] * o0[1]) + (o0[2] * o0[2] + o0[3] * o0[3])) + ((o1[0] * o1[0] + o1[1] * o1[1]) + (o1[2] * o1[2] + o1[3] * o1[3]));
                    }
                }
                if (!LAST) {
                    ss += __shfl_xor(ss, 16); ss += __shfl_xor(ss, 32);
                    if (fq == 0) ssq_out[(size_t)row * 16 + u.pn * 4 + wc] = ss;
                }
            }
    }
};
struct EpiPool {
    const float* scale; bf16_t* MIX;
    __device__ __forceinline__ void operator()(const AccT& acc, const pg8::Unit& u, int wr, int wc, int fr, int fq) const {
        const int col0 = u.pn * 256 + 32 * wc + 8 * fq;
        f32x4 sv[2][2];
#pragma unroll
        for (int bj = 0; bj < 2; ++bj)
#pragma unroll
            for (int n = 0; n < 2; ++n) sv[bj][n] = *(const f32x4*)(scale + col0 + 128 * bj + 4 * n);
#pragma unroll
        for (int ai = 0; ai < 2; ++ai)
#pragma unroll
            for (int m = 0; m < 4; ++m) {
                const int row = u.pm * 256 + ai * 128 + wr * 64 + m * 16 + fr;
#pragma unroll
                for (int bj = 0; bj < 2; ++bj)
                    *(u32x4*)(MIX + (size_t)row * 1024 + 512 + col0 + 128 * bj) = pack8(acc[ai][bj][m][0] * sv[bj][0], acc[ai][bj][m][1] * sv[bj][1]);
            }
    }
};
struct EpiFfn2 {
    const LAS float* rst; const float* cw; const float* cb; bf16_t* ACT; float* UH; float* UT; LAS float* tl;
    __device__ __forceinline__ void operator()(AccT& acc, const pg8::Unit& u, int wr, int wc, int fr, int fq) const {
        const int f0 = u.pn * 128 + 32 * wc + 8 * fq, t0 = u.pm * 256, cl = 32 * wc + 8 * fq;
        const bool bstart = (t0 & 8191) == 0;
        LAS float* wt = tl + 4864;
        const int wt_t = (4 * wr + wc) * 64 + fq * 16 + fr;
        f32x4 wreg = (f32x4){0.f, 0.f, 0.f, 0.f};
        if (wt_t < 256) { const int kind = wt_t >> 6, hf = (wt_t & 63) >> 5, c = ((wt_t & 63) * 4) & 127;
            wreg = *(const f32x4*)((kind < 3 ? cw + kind * FF2 : cb) + hf * FF + u.pn * 128 + c); }
#pragma unroll
        for (int ai = 0; ai < 2; ++ai)
#pragma unroll
            for (int m = 0; m < 4; ++m) {
                const float rs = rst[u.idx * 256 + 128 * ai + 64 * wr + 16 * m + fr];
#pragma unroll
                for (int bj = 0; bj < 2; ++bj)
#pragma unroll
                    for (int n = 0; n < 2; ++n) acc[ai][bj][m][n] = acc[ai][bj][m][n] * rs;
            }
        if (fr >= 14) {
#pragma unroll
            for (int ai = 0; ai < 2; ++ai)
#pragma unroll
                for (int bj = 0; bj < 2; ++bj)
#pragma unroll
                    for (int n = 0; n < 2; ++n) *(LAS f32x4*)(tl + (((2 * ai + wr) * 2 + (fr - 14)) * 256 + 128 * bj + cl + 4 * n)) = acc[ai][bj][3][n];
            if (wr == 1) {
#pragma unroll
                for (int bj = 0; bj < 2; ++bj)
#pragma unroll
                    for (int n = 0; n < 2; ++n) *(f32x4*)(UT + (size_t)(u.pm * 2 + (fr - 14)) * FF2 + bj * FF + f0 + 4 * n) = acc[1][bj][3][n];
            }
        }
        if (wr == 0 && fr < 2) {
#pragma unroll
            for (int bj = 0; bj < 2; ++bj)
#pragma unroll
                for (int n = 0; n < 2; ++n) *(f32x4*)(UH + (size_t)(u.pm * 2 + fr) * FF2 + bj * FF + f0 + 4 * n) = acc[0][bj][0][n];
        }
        if (wt_t < 256) *(LAS f32x4*)(wt + 4 * wt_t) = wreg;
        asm volatile("s_waitcnt lgkmcnt(0)" ::: "memory"); __builtin_amdgcn_s_barrier(); asm volatile("" ::: "memory");
        bf16_t* abase = ACT + (size_t)(u.pm * (FF / 64) + 2 * u.pn + (wc >> 1)) * 16384 + (8 * wr + (wc & 1)) * 512 + (((fr * 64 + 16 * fq) ^ ((fr >> 3) << 5)) >> 1);
#pragma unroll
        for (int n = 0; n < 2; ++n) {
            asm volatile("" ::: "memory");
            f32x4 w0[2], w1[2], w2[2], bb[2];
#pragma unroll
            for (int bj = 0; bj < 2; ++bj) { const LAS float* wp = wt + bj * 128 + cl + 4 * n;
                w0[bj] = *(const LAS f32x4*)(wp); w1[bj] = *(const LAS f32x4*)(wp + 256); w2[bj] = *(const LAS f32x4*)(wp + 512); bb[bj] = *(const LAS f32x4*)(wp + 768); }
#pragma unroll
            for (int ai = 0; ai < 2; ++ai) {
                const int blk = 2 * ai + wr;
                f32x4 e1[2], e2[2];
#pragma unroll
                for (int bj = 0; bj < 2; ++bj) {
                    f32x4 v62 = (f32x4){0.f, 0.f, 0.f, 0.f}, v63 = v62;
                    if (blk > 0) { v62 = *(const LAS f32x4*)(tl + (((blk - 1) * 2 + 0) * 256 + 128 * bj + cl + 4 * n)); v63 = *(const LAS f32x4*)(tl + (((blk - 1) * 2 + 1) * 256 + 128 * bj + cl + 4 * n)); }
                    const f32x4 z = (f32x4){0.f, 0.f, 0.f, 0.f};
                    e1[bj] = (fr == 0) ? v63 : z; e2[bj] = (fr == 0) ? v62 : ((fr == 1) ? v63 : z); }
#pragma unroll
                for (int m = 0; m < 4; ++m) {
                    f32x4 cv[2];
#pragma unroll
                    for (int bj = 0; bj < 2; ++bj)
#pragma unroll
                        for (int e = 0; e < 4; ++e) {
                            const float cur = acc[ai][bj][m][n][e];
                            float p1 = dpp0<0x111>(cur), p2 = dpp0<0x112>(cur);
                            if (m > 0) { const float prv = acc[ai][bj][m - 1][n][e]; p1 += dpp0<0x10F>(prv); p2 += dpp0<0x10E>(prv); }
                            else { p1 += e1[bj][e]; p2 += e2[bj][e]; }
                            cv[bj][e] = bb[bj][e] + w2[bj][e] * cur + w1[bj][e] * p1 + w0[bj][e] * p2;
                        }
                    u32x2 w; float r[4];
#pragma unroll
                    for (int e = 0; e < 4; ++e) { const float a = cv[0][e]; r[e] = a * __builtin_amdgcn_rcpf(1.0f + __builtin_amdgcn_exp2f(-a * LOG2E)) * cv[1][e]; }
                    w.x = cvt_pk_bf16(r[0], r[1]); w.y = cvt_pk_bf16(r[2], r[3]);
                    const bool deferred = (blk == 0) && (m == 0) && (fr < 2) && !bstart;
                    if (!deferred) *(u32x2*)(abase + ai * 8192 + m * 1024 + n * 4) = w;
                }
            }
        }
    }
};
__device__ __forceinline__ void ffn_fixup(int pm, const float* __restrict__ UH, const float* __restrict__ UT, const float* __restrict__ cw, const float* __restrict__ cb, bf16_t* __restrict__ ACT, int tid) {
    if (((pm * 256) & 8191) == 0) return;
    for (int f = tid; f < FF; f += 512) {
        float cva[2], cvg[2];
#pragma unroll
        for (int hg = 0; hg < 2; ++hg) {
            const int ch = hg * FF + f;
            const float h0 = UH[(size_t)(pm * 2 + 0) * FF2 + ch], h1 = UH[(size_t)(pm * 2 + 1) * FF2 + ch];
            const float q2 = UT[(size_t)((pm - 1) * 2 + 0) * FF2 + ch], q1 = UT[(size_t)((pm - 1) * 2 + 1) * FF2 + ch];
            const float w0 = cw[ch], w1 = cw[FF2 + ch], w2 = cw[2 * FF2 + ch], bb = cb[ch];
            const float r0 = bb + w2 * h0 + w1 * q1 + w0 * q2, r1 = bb + w2 * h1 + w1 * h0 + w0 * q1;
            if (hg == 0) { cva[0] = r0; cva[1] = r1; } else { cvg[0] = r0; cvg[1] = r1; }
        }
#pragma unroll
        for (int r = 0; r < 2; ++r) { const float a = cva[r]; const float y = a * __builtin_amdgcn_rcpf(1.0f + __builtin_amdgcn_exp2f(-a * LOG2E)) * cvg[r];
            ACT[pg8::aimg_off(pm * 256 + r, f, FF / 64)] = (bf16_t)f2bf(y); }
    }
}

constexpr size_t MiB = 1u << 20;
constexpr size_t WS_WINE = 2 * MiB, WS_POOLW = 6 * MiB, WS_WOUTE = 7 * MiB, WS_WINO = 9 * MiB, WS_WOUTO = 16 * MiB, WS_WUP = 18 * MiB, WS_WDN = 40 * MiB;
constexpr size_t WS_SSQ = 52 * MiB;
constexpr size_t WS_DEC = 60 * MiB;
constexpr size_t WS_ALOW = 61 * MiB;
constexpr size_t WS_XB = 64 * MiB + 65536;
constexpr size_t WS_P0 = 130 * MiB;
constexpr size_t WS_Q = WS_P0, WS_K = WS_P0 + 32 * MiB, WS_VT = WS_P0 + 64 * MiB;
constexpr size_t WS_XP = WS_P0 + 96 * MiB;
constexpr size_t WS_R = WS_P0 + 128 * MiB;
constexpr size_t WS_MIX = 322 * MiB;
constexpr size_t WS_POOLED = 386 * MiB;
constexpr size_t WS_KDT = 386 * MiB, WS_O = 418 * MiB;
constexpr size_t WS_ACT = 130 * MiB;
constexpr size_t WS_UH = 482 * MiB, WS_UT = 490 * MiB;
constexpr size_t WS_END = 498 * MiB;

struct Args {
    const float* in[19]; float* out; unsigned char* ws; int ph_lo, ph_hi;
};
constexpr int N_PHASES = 14;
constexpr int LDS_BYTES = 163840;

#define XB_TMO      128
#define XB_XCNT(j)  (256  + 64 * (j))
#define XB_XSUB(j)  (1280 + 64 * (j))
#define XB_XGEN(j)  (2304 + 64 * (j))
#define XB_TOP      3328
#define XB_TOPGEN   3392
#define XCD_BAR_WORDS 3456
#define XB_SPIN_CAP (1u << 18)

__device__ __forceinline__ unsigned xb_ld(unsigned* p)              { return __hip_atomic_load(p, __ATOMIC_RELAXED, __HIP_MEMORY_SCOPE_AGENT); }
__device__ __forceinline__ unsigned xb_add(unsigned* p, unsigned v) { return __hip_atomic_fetch_add(p, v, __ATOMIC_RELAXED, __HIP_MEMORY_SCOPE_AGENT); }
__device__ __forceinline__ unsigned xb_xcc_id() { return (unsigned)__builtin_amdgcn_s_getreg((3 << 11) | 20) & 0xFu; }
#define XB_SPIN(cond, bar) do { unsigned _sp = 0; while (cond) { __builtin_amdgcn_s_sleep(1); \
    if ((++_sp & 255u) == 0u) { if (xb_ld(&(bar)[XB_TMO])) break; if (_sp > XB_SPIN_CAP) { atomicAdd(&(bar)[XB_TMO], 1u); break; } } } } while (0)

struct XcdBarrier {
    unsigned* bar; unsigned x;
    volatile LAS unsigned* st;
};

__device__ __forceinline__ XcdBarrier xcd_barrier_post(unsigned* bar, volatile LAS unsigned* st) {
    XcdBarrier b; b.bar = bar; b.x = xb_xcc_id(); b.st = st;
    if (threadIdx.x == 0) (void)xb_add(&bar[XB_XCNT(b.x)], 1u);
    return b;
}
__device__ __forceinline__ void xcd_barrier_complete(unsigned* bar, unsigned x, unsigned& nloc, unsigned& nx) {
    const unsigned G = gridDim.x * gridDim.y * gridDim.z;
    unsigned sum, cnt, mine, sp = 0u;
    for (;;) {
        sum = 0u; cnt = 0u; mine = 0u;
#pragma unroll
        for (unsigned j = 0; j < 16; ++j) { const unsigned c = xb_ld(&bar[XB_XCNT(j)]); sum += c; cnt += (c > 0u) ? 1u : 0u; mine = (j == x) ? c : mine; }
        if (sum == G) break;
        __builtin_amdgcn_s_sleep(1);
        if ((++sp & 255u) == 0u) { if (xb_ld(&bar[XB_TMO])) break; if (sp > XB_SPIN_CAP) { atomicAdd(&bar[XB_TMO], 1u); break; } }
    }
    nloc = mine > 0u ? mine : 1u; nx = cnt > 0u ? cnt : 1u;
}

__device__ __forceinline__ void xcd_barrier(const XcdBarrier& b) {
    asm volatile("s_waitcnt vmcnt(0)" ::: "memory");
    __syncthreads();
    if (threadIdx.x == 0) {
        unsigned* bar = b.bar;
        __builtin_amdgcn_s_waitcnt(0);
        unsigned nloc = b.st[0], nx = b.st[1];
        if (nloc == 0u) { xcd_barrier_complete(bar, b.x, nloc, nx); b.st[0] = nloc; b.st[1] = nx; }
        const unsigned old = xb_add(&bar[XB_XSUB(b.x)], 1u);
        const unsigned gen = old / nloc;
        if (old + 1u == (gen + 1u) * nloc) {
            __builtin_amdgcn_fence(__ATOMIC_RELEASE, "agent");
            asm volatile("s_waitcnt vmcnt(0)" ::: "memory");
            const unsigned og = xb_add(&bar[XB_TOP], 1u);
            const unsigned tg = og / nx;
            if (og + 1u != (tg + 1u) * nx) XB_SPIN(xb_ld(&bar[XB_TOP]) < (tg + 1u) * nx, bar);
            __builtin_amdgcn_fence(__ATOMIC_ACQUIRE, "agent");
            asm volatile("s_waitcnt vmcnt(0)" ::: "memory");
        } else {
            XB_SPIN(xb_ld(&bar[XB_TOP]) < (gen + 1u) * nx, bar);
            __builtin_amdgcn_fence(__ATOMIC_ACQUIRE, "agent");
            asm volatile("s_waitcnt vmcnt(0)" ::: "memory");
        }
    }
    __syncthreads();
}


__device__ __forceinline__ float wave_sum(float v) {
#pragma unroll
    for (int o = 1; o < 64; o <<= 1) v += __shfl_xor(v, o);
    return v;
}
struct MapId { __device__ __forceinline__ int operator()(int n) const { return n; } };
struct MapHead { __device__ __forceinline__ int operator()(int n) const { const int a = n & 255; return (n & ~255) + 128 * ((a & 63) >> 5) + 32 * (a >> 6) + (a & 31); } };
struct MapFfn { __device__ __forceinline__ int operator()(int n) const { const int half = n >= FF ? 1 : 0, f = n - half * FF; return 256 * (f >> 7) + 128 * half + (f & 127); } };

template <class RowMap>
__device__ __forceinline__ void transpose_item(const float* W, int K, int N, const float* gain, bf16_t* WT, RowMap rm, LAS float* scr, int item, int lane) {
    const int nblk = (N + 31) / 32, kb = item / nblk, nb = item % nblk, k0 = 64 * kb, n0 = 32 * nb;
    const int nn = n0 + (lane & 31);
    float tv[32];
#pragma unroll
    for (int i = 0; i < 32; ++i) { const int kk = 2 * i + (lane >> 5); tv[i] = (nn < N) ? W[(size_t)(k0 + kk) * N + nn] : 0.f; }
    if (gain) {
#pragma unroll
        for (int i = 0; i < 32; ++i) tv[i] *= gain[k0 + 2 * i + (lane >> 5)];
    }
#pragma unroll
    for (int i = 0; i < 32; ++i) scr[(2 * i + (lane >> 5)) * 33 + (lane & 31)] = tv[i];
    asm volatile("s_waitcnt lgkmcnt(0)" ::: "memory");
    const int c = lane & 7;
#pragma unroll
    for (int j = 0; j < 4; ++j) { const int nl = (lane >> 3) + 8 * j; const LAS float* s = scr + (8 * c) * 33 + nl;
        u32x4 o; o.x = cvt_pk_bf16(s[0 * 33], s[1 * 33]); o.y = cvt_pk_bf16(s[2 * 33], s[3 * 33]); o.z = cvt_pk_bf16(s[4 * 33], s[5 * 33]); o.w = cvt_pk_bf16(s[6 * 33], s[7 * 33]);
        if (n0 + nl < N) *(u32x4*)(WT + pg8::bimg_off(rm(n0 + nl), k0 + 8 * c, K / 64)) = o; }
    asm volatile("s_waitcnt lgkmcnt(0)" ::: "memory");
}

template <bool DIAG>
__device__ __forceinline__ void sb_tile(const bf16x8 (&kf)[4], const bf16x8 (&vf)[4], const bf16x8 (&qf)[4], f32x16& o0, f32x16& o1, float& c, int rel0, int hi) {
    f32x16 s;
#pragma unroll
    for (int r = 0; r < 16; ++r) s[r] = 0.f;
#pragma unroll
    for (int d0 = 0; d0 < 4; ++d0) s = __builtin_amdgcn_mfma_f32_32x32x16_bf16(kf[d0], qf[d0], s, 0, 0, 0);
    float L[16]; float tot = 0.f;
#pragma unroll
    for (int r = 15; r >= 0; --r) {
        const float z = s[r];
        const float sp = fmaxf(z, 0.f) + __builtin_amdgcn_logf(1.0f + __builtin_amdgcn_exp2f(-fabsf(z)));
        if (DIAG) tot += (r < rel0) ? -sp : 0.f; else tot -= sp;
        L[r] = tot;
    }
    const float tot_o = __shfl_xor(tot, 32);
    const float add = c + (hi == 0 ? tot_o : 0.f);
    float w[16];
#pragma unroll
    for (int r = 0; r < 16; ++r) {
        const float e = __builtin_amdgcn_exp2f(s[r] + L[r] + add);
        w[r] = DIAG ? ((r < rel0) ? e : 0.f) : e;
    }
    c += tot + tot_o;
    u32x4 p0, p1;
    p0.x = cvt_pk_bf16(w[0], w[1]); p0.y = cvt_pk_bf16(w[2], w[3]); p0.z = cvt_pk_bf16(w[4], w[5]); p0.w = cvt_pk_bf16(w[6], w[7]);
    p1.x = cvt_pk_bf16(w[8], w[9]); p1.y = cvt_pk_bf16(w[10], w[11]); p1.z = cvt_pk_bf16(w[12], w[13]); p1.w = cvt_pk_bf16(w[14], w[15]);
    const bf16x8 pf0 = __builtin_bit_cast(bf16x8, p0), pf1 = __builtin_bit_cast(bf16x8, p1);
    o0 = __builtin_amdgcn_mfma_f32_32x32x16_bf16(vf[0], pf0, o0, 0, 0, 0);
    o0 = __builtin_amdgcn_mfma_f32_32x32x16_bf16(vf[1], pf1, o0, 0, 0, 0);
    o1 = __builtin_amdgcn_mfma_f32_32x32x16_bf16(vf[2], pf0, o1, 0, 0, 0);
    o1 = __builtin_amdgcn_mfma_f32_32x32x16_bf16(vf[3], pf1, o1, 0, 0, 0);
}
__device__ __forceinline__ void sb_attn_unit(const bf16_t* __restrict__ Q, const bf16_t* __restrict__ Kb, const bf16_t* __restrict__ VT, bf16_t* __restrict__ MIX, int b, int h, int qb, int lane) {
    const int q = lane & 31, hi = lane >> 5, q0 = qb * 32;
    const size_t rowbase = (size_t)b * SEQ;
    bf16x8 qf[4];
    const size_t hb = (size_t)(b * 8 + h) * 8192;
    { const bf16_t* qp = Q + (hb + q0 + q) * 64 + 8 * hi;
#pragma unroll
      for (int d0 = 0; d0 < 4; ++d0) qf[d0] = *(const bf16x8*)(qp + 16 * d0); }
    const bf16_t* kp = Kb + hb * 64 + lane * 8;
    const bf16_t* vp = VT + hb * 64 + lane * 8;
    f32x16 o0, o1;
#pragma unroll
    for (int r = 0; r < 16; ++r) { o0[r] = 0.f; o1[r] = 0.f; }
    float c = 0.f;
    bf16x8 kf[4], vf[4], kn[4], vn[4];
#pragma unroll
    for (int i = 0; i < 4; ++i) { kf[i] = *(const bf16x8*)(kp + (size_t)q0 * 64 + 512 * i); vf[i] = *(const bf16x8*)(vp + (size_t)q0 * 64 + 512 * i); }
    int kvn = q0 >= 32 ? q0 - 32 : 0;
#pragma unroll
    for (int i = 0; i < 4; ++i) { kn[i] = *(const bf16x8*)(kp + (size_t)kvn * 64 + 512 * i); vn[i] = *(const bf16x8*)(vp + (size_t)kvn * 64 + 512 * i); }
    sb_tile<true>(kf, vf, qf, o0, o1, c, q - 16 * hi, hi);
    for (int kv0 = q0 - 32; kv0 >= 0; kv0 -= 32) {
#pragma unroll
        for (int i = 0; i < 4; ++i) { kf[i] = kn[i]; vf[i] = vn[i]; }
        kvn = kv0 >= 32 ? kv0 - 32 : 0;
#pragma unroll
        for (int i = 0; i < 4; ++i) { kn[i] = *(const bf16x8*)(kp + (size_t)kvn * 64 + 512 * i); vn[i] = *(const bf16x8*)(vp + (size_t)kvn * 64 + 512 * i); }
        sb_tile<false>(kf, vf, qf, o0, o1, c, 0, hi);
        if (__all(c < -150.1f)) break;
    }
    bf16_t* op = MIX + (rowbase + q0 + q) * 1024 + h * 64 + 4 * hi;
#pragma unroll
    for (int g = 0; g < 4; ++g) {
        u32x2 a, bq;
        a.x = cvt_pk_bf16(o0[4 * g], o0[4 * g + 1]); a.y = cvt_pk_bf16(o0[4 * g + 2], o0[4 * g + 3]);
        bq.x = cvt_pk_bf16(o1[4 * g], o1[4 * g + 1]); bq.y = cvt_pk_bf16(o1[4 * g + 2], o1[4 * g + 3]);
        *(u32x2*)(op + 8 * g) = a; *(u32x2*)(op + 32 + 8 * g) = bq;
    }
}

#ifndef P9_DEPTH
#define P9_DEPTH 4
#endif
constexpr int P9_NCT = 1;
constexpr int P9_SBUF = 16 * P9_NCT * 272;
template <bool RO>
__device__ __forceinline__ void p9_job(LAS unsigned char* lds, const bf16_t* __restrict__ kap, const bf16_t* __restrict__ vbp, const float* __restrict__ dcp, const bf16_t* __restrict__ qap, bf16_t* __restrict__ op, int wave, int c16, int kq) {
    constexpr int PD = P9_DEPTH, NCT = P9_NCT;
    f32x4 S[NCT];
#pragma unroll
    for (int ct = 0; ct < NCT; ++ct) S[ct] = (f32x4){0.f, 0.f, 0.f, 0.f};
    bf16x8 ka[PD][2], vb[PD][NCT][2], qa[PD][4]; f32x4 dc[PD];
#define P9_LOAD(u, cc) do { ka[u][0] = *(const bf16x8*)(kap + (size_t)(cc) * 8192); ka[u][1] = *(const bf16x8*)(kap + (size_t)(cc) * 8192 + 512); \
        _Pragma("unroll") for (int ct = 0; ct < NCT; ++ct) { vb[u][ct][0] = *(const bf16x8*)(vbp + (size_t)(cc) * 16384 + ct * 1024); vb[u][ct][1] = *(const bf16x8*)(vbp + (size_t)(cc) * 16384 + ct * 1024 + 512); } \
        dc[u] = *(const f32x4*)(dcp + (size_t)(cc) * 512); \
        if (RO) { _Pragma("unroll") for (int ks = 0; ks < 4; ++ks) qa[u][ks] = *(const bf16x8*)(qap + (size_t)(cc) * 8192 + 512 * ks); } } while (0)
#pragma unroll
    for (int u = 0; u < PD; ++u) P9_LOAD(u, u);
    for (int c0 = 0; c0 < 128; c0 += PD) {
#pragma unroll
        for (int u = 0; u < PD; ++u) {
            const int c = c0 + u;
            LAS unsigned char* sl = lds + (u & 1) * P9_SBUF;
#pragma unroll
            for (int ct = 0; ct < NCT; ++ct) {
                S[ct] = S[ct] * dc[u];
                S[ct] = __builtin_amdgcn_mfma_f32_16x16x32_bf16(ka[u][0], vb[u][ct][0], S[ct], 0, 0, 0);
                S[ct] = __builtin_amdgcn_mfma_f32_16x16x32_bf16(ka[u][1], vb[u][ct][1], S[ct], 0, 0, 0);
            }
#pragma unroll
            for (int ct = 0; ct < NCT; ++ct) { u32x2 wv; wv.x = cvt_pk_bf16(S[ct][0], S[ct][1]); wv.y = cvt_pk_bf16(S[ct][2], S[ct][3]);
                *(LAS u32x2*)(sl + (16 * ct + c16) * 272 + (16 * wave + 4 * kq) * 2) = wv; }
            asm volatile("s_waitcnt lgkmcnt(0)" ::: "memory"); __builtin_amdgcn_s_barrier(); asm volatile("" ::: "memory");
            if (RO) {
                bf16_t* o2 = op + (size_t)c * 64 * 1024;
#pragma unroll
                for (int ct = 0; ct < NCT; ++ct) {
                    f32x4 o = (f32x4){0.f, 0.f, 0.f, 0.f};
#pragma unroll
                    for (int ks = 0; ks < 4; ++ks) {
                        const bf16x8 sb = *(const LAS bf16x8*)(sl + (16 * ct + c16) * 272 + (32 * ks + 8 * kq) * 2);
                        o = __builtin_amdgcn_mfma_f32_16x16x32_bf16(qa[u][ks], sb, o, 0, 0, 0);
                    }
#pragma unroll
                    for (int i = 0; i < 4; ++i) o2[(size_t)i * 1024 + 16 * ct] = (bf16_t)f2bf(o[i]);
                }
            }
            const int cn = c + PD < 128 ? c + PD : 127;
            P9_LOAD(u, cn);
        }
    }
#undef P9_LOAD
}

__global__ void __launch_bounds__(512, 2) hybrid_fwd(Args args) {
    extern __shared__ __attribute__((aligned(16))) unsigned char lds_raw[];
    LAS unsigned char* lds = (LAS unsigned char*)lds_raw;
#define PH_IDS int tid = threadIdx.x; asm volatile("" : "+v"(tid)); const int lane = tid & 63, wave = __builtin_amdgcn_readfirstlane(tid >> 6); \
    const int G = gridDim.x, blk = blockIdx.x; const int gw = blk * 8 + wave, NGW = G * 8; (void)lane; (void)gw; (void)NGW; (void)G; (void)blk;
#define ws (args.ws)
#define x_in (args.in[0])
#define mix_norm_even (args.in[1])
#define w_in_even (args.in[2])
#define sb_q_gain (args.in[3])
#define sb_k_gain (args.in[4])
#define pool_w (args.in[5])
#define pool_scale (args.in[6])
#define w_out_even (args.in[7])
#define mix_norm_odd (args.in[8])
#define w_in_odd (args.in[9])
#define gla_w_a2 (args.in[10])
#define gla_b_a (args.in[11])
#define gla_o_gain (args.in[12])
#define w_out_odd (args.in[13])
#define ffn_norm (args.in[14])
#define ffn_w_up (args.in[15])
#define ffn_conv_w (args.in[16])
#define ffn_conv_b (args.in[17])
#define ffn_w_down (args.in[18])
#define out (args.out)
#define WinE ((bf16_t*)(ws + WS_WINE))
#define PoolW ((bf16_t*)(ws + WS_POOLW))
#define WoutE ((bf16_t*)(ws + WS_WOUTE))
#define WinO ((bf16_t*)(ws + WS_WINO))
#define WoutO ((bf16_t*)(ws + WS_WOUTO))
#define Wup ((bf16_t*)(ws + WS_WUP))
#define Wdn ((bf16_t*)(ws + WS_WDN))
#define SSQ ((float*)(ws + WS_SSQ))
#define DEC ((float*)(ws + WS_DEC))
#define XB ((bf16_t*)(ws + WS_XB))
#define Qb ((bf16_t*)(ws + WS_Q))
#define Kb ((bf16_t*)(ws + WS_K))
#define VT ((bf16_t*)(ws + WS_VT))
#define XP ((bf16_t*)(ws + WS_XP))
#define Rb ((bf16_t*)(ws + WS_R))
#define MIX ((bf16_t*)(ws + WS_MIX))
#define POOLED ((bf16_t*)(ws + WS_POOLED))
#define KDT ((bf16_t*)(ws + WS_KDT))
#define Ob ((bf16_t*)(ws + WS_O))
#define ACT ((bf16_t*)(ws + WS_ACT))
    constexpr size_t SSQ_STRIDE = (size_t)M * 16;

    const int lo = args.ph_lo, hi = args.ph_hi;
#if MK_SINGLE
    if (threadIdx.x < 16) ((LAS unsigned*)(lds + LDS_BYTES - 64))[threadIdx.x] = 0u;
    __syncthreads();
    if (lo < 0) cg::this_grid().sync();
    const XcdBarrier gbar = xcd_barrier_post((unsigned*)(ws) + 1024, (volatile LAS unsigned*)(lds + LDS_BYTES - 64));
#endif
#ifndef PHMASK
#define PHMASK 0xffff
#endif
#define IN(k) (((PHMASK >> (k)) & 1) && lo <= (k) && (k) < hi)
#if MK_SINGLE
#define SEAM(k) do { if (IN(k) && IN((k) + 1)) { xcd_barrier(gbar); } } while (0)
#else
#define SEAM(k) do { } while (0)
#endif

    if (IN(0)) {
        PH_IDS
        LAS float* scr = (LAS float*)(lds + wave * 16384);
        constexpr int I_INE = 16 * 64, I_OUTE = 16 * 32, I_INO = 16 * 97, I_OUTO = 16 * 32, I_UP = 16 * 176, I_DN = 44 * 32;
        constexpr int NITEMS = I_INE + I_OUTE + I_INO + I_OUTO + 2 * I_UP + 2 * I_DN;
        for (int it = gw; it < NITEMS; it += NGW) {
            int r = it;
            if (r < I_INE) { transpose_item(w_in_even, 1024, 2048, mix_norm_even, WinE, MapHead(), scr, r, lane); continue; } r -= I_INE;
            if (r < I_OUTE) { transpose_item(w_out_even, 1024, 1024, (const float*)nullptr, WoutE, MapId(), scr, r, lane); continue; } r -= I_OUTE;
            if (r < I_INO) { transpose_item(w_in_odd, 1024, 3088, mix_norm_odd, WinO, MapId(), scr, r, lane); continue; } r -= I_INO;
            if (r < I_OUTO) { transpose_item(w_out_odd, 1024, 1024, (const float*)nullptr, WoutO, MapId(), scr, r, lane); continue; } r -= I_OUTO;
            if (r < 2 * I_UP) { const int l = r / I_UP; transpose_item(ffn_w_up + (size_t)l * 1024 * FF2, 1024, FF2, ffn_norm + l * 1024, Wup + (size_t)l * FF2 * 1024, MapFfn(), scr, r % I_UP, lane); continue; } r -= 2 * I_UP;
            { const int l = r / I_DN; transpose_item(ffn_w_down + (size_t)l * FF * 1024, FF, 1024, (const float*)nullptr, Wdn + (size_t)l * 1024 * FF, MapId(), scr, r % I_DN, lane); }
        }
        for (int i = blk * 512 + tid; i < 512 * 256; i += G * 512) {
            const int n = i >> 8, kl = i & 255, g = n >> 7, d = n & 127, c = kl & 127;
            const float v = ((kl >> 7) == (g & 1)) ? pool_w[(size_t)(g * 128 + c) * 128 + d] : 0.f;
            PoolW[pg8::bimg_off(n, kl, 4)] = (bf16_t)f2bf(v);
        }
        for (int m0 = gw * 4; m0 < M; m0 += NGW * 4) {
            f32x4 v[4][4];
#pragma unroll
            for (int r = 0; r < 4; ++r)
#pragma unroll
                for (int j = 0; j < 4; ++j) v[r][j] = ((const f32x4*)(x_in + (size_t)(m0 + r) * DM) + lane)[64 * j];
#pragma unroll
            for (int r = 0; r < 4; ++r) {
                float s = 0.f;
                unsigned long long* o8 = (unsigned long long*)(XB + (size_t)(m0 + r) * DM) + lane;
#pragma unroll
                for (int j = 0; j < 4; ++j) { const f32x4 w = v[r][j]; s += (w[0] * w[0] + w[1] * w[1]) + (w[2] * w[2] + w[3] * w[3]);
                    o8[64 * j] = (unsigned long long)cvt_pk_bf16(w[0], w[1]) | ((unsigned long long)cvt_pk_bf16(w[2], w[3]) << 32); }
                s = wave_sum(s);
                if (lane < 16) SSQ[(size_t)(m0 + r) * 16 + lane] = (lane == 0) ? s : 0.f;
            }
        }
    }
    SEAM(0);
    if (IN(1)) {
        PH_IDS
        pg8::Gemm g{XB, WinE, 1024, 1024, 1024, 0, 128, 8}; pg8::StaticOrder S; S.init(128, 8, G, blk);
        LAS float* rst = (LAS float*)(lds + 139264);
        { pg8::Unit pu; for (int i = 0; S.next(i, pu); ++i) if (tid < 256) rst[i * 256 + tid] = row_rstd(SSQ, pu.pm * 256 + tid);
          if (tid >= 256 && tid < 384) rst[2816 + tid - 256] = (tid < 320) ? sb_q_gain[tid - 256] : sb_k_gain[tid - 320];
          __syncthreads(); }
        EpiIn0 E{rst, sb_q_gain, sb_k_gain, Qb, Kb, VT, XP};
        pg8::gemm_phase<EpiIn0, false>(lds, g, S, E);
    }
    SEAM(1);
    if (IN(2)) {
        PH_IDS
        for (int uidx = gw; uidx < NB * 8 * 256; uidx += NGW) {
            const int qb = uidx & 255, bh = uidx >> 8;
            sb_attn_unit(Qb, Kb, VT, MIX, bh >> 3, bh & 7, qb, lane);
        }
    }
    if (IN(3)) {
        PH_IDS
        pg8::Gemm g{POOLED, PoolW, 512, 256, 256, 256, 128, 2}; pg8::StaticOrder S; S.init(128, 2, G, blk);
        { pg8::Unit pu;
          for (int i = 0; S.next(i, pu); ++i)
            for (int it = tid; it < 256 * 32; it += 512) {
                const int t = pu.pm * 256 + (it >> 5), cg8 = pu.pn * 32 + (it & 31), tl = t & 8191, w = 2 << (cg8 >> 4);
                const bf16_t* xp = XP + (size_t)t * 512 + cg8 * 8;
                float sum[8];
#pragma unroll
                for (int e = 0; e < 8; ++e) sum[e] = 0.f;
                u32x4 x0 = (u32x4){0u, 0u, 0u, 0u};
#pragma unroll
                for (int j = 0; j < 16; ++j) {
                    if (j < w && tl - j >= 0) {
                        const u32x4 v = *(const u32x4*)(xp - (size_t)j * 512);
                        if (j == 0) x0 = v;
#pragma unroll
                        for (int e = 0; e < 4; ++e) { sum[2 * e] += __builtin_bit_cast(float, v[e] << 16); sum[2 * e + 1] += __builtin_bit_cast(float, v[e] & 0xffff0000u); }
                    }
                }
                const float inv = 1.0f / (float)(tl + 1 < w ? tl + 1 : w);
                float p[8];
#pragma unroll
                for (int e = 0; e < 4; ++e) { p[2 * e] = sum[2 * e] * inv - __builtin_bit_cast(float, x0[e] << 16); p[2 * e + 1] = sum[2 * e + 1] * inv - __builtin_bit_cast(float, x0[e] & 0xffff0000u); }
                u32x4 o; o.x = cvt_pk_bf16(p[0], p[1]); o.y = cvt_pk_bf16(p[2], p[3]); o.z = cvt_pk_bf16(p[4], p[5]); o.w = cvt_pk_bf16(p[6], p[7]);
                *(u32x4*)(POOLED + (size_t)t * 512 + cg8 * 8) = o;
            }
          asm volatile("s_waitcnt vmcnt(0)" ::: "memory"); __syncthreads(); }
        EpiPool E{pool_scale, MIX};
        pg8::gemm_phase<EpiPool, false>(lds, g, S, E);
    }
    SEAM(3);
    if (IN(4)) {
        PH_IDS
        pg8::Gemm g{MIX, WoutE, 1024, 1024, 1024, 0, 128, 4}; pg8::StaticOrder S; S.init(128, 4, G, blk);
        EpiRes<false> E{XB, out, SSQ + SSQ_STRIDE};
        pg8::gemm_phase<EpiRes<false>, false>(lds, g, S, E);
    }
    SEAM(4);
    if (IN(5)) {
        PH_IDS
        pg8::Gemm g{XB, Wup, 1024, 1024, 1024, 0, 128, 22}; pg8::StaticOrder S; S.init(128, 22, G, blk);
        LAS float* rst = (LAS float*)(lds + 139264);
        { pg8::Unit pu; for (int i = 0; S.next(i, pu); ++i) if (tid < 256) rst[i * 256 + tid] = row_rstd(SSQ + SSQ_STRIDE, pu.pm * 256 + tid);
          __syncthreads(); }
        EpiFfn2 E{rst, ffn_conv_w, ffn_conv_b, ACT, (float*)(ws + WS_UH), (float*)(ws + WS_UT), (LAS float*)(lds + 131072)};
        pg8::gemm_phase<EpiFfn2, false>(lds, g, S, E);
    }
    SEAM(5);
    if (IN(6)) {
        PH_IDS
        pg8::Gemm g{ACT, Wdn, FF, FF, FF, 0, 128, 4}; pg8::StaticOrder S; S.init(128, 4, G, blk);
        { pg8::Unit pu; for (int i = 0; S.next(i, pu); ++i) ffn_fixup(pu.pm, (const float*)(ws + WS_UH), (const float*)(ws + WS_UT), ffn_conv_w, ffn_conv_b, ACT, tid);
          asm volatile("s_waitcnt vmcnt(0)" ::: "memory"); __syncthreads(); }
        EpiRes<false> E{XB, out, SSQ + 2 * SSQ_STRIDE};
        pg8::gemm_phase<EpiRes<false>, true>(lds, g, S, E);
    }
    SEAM(6);
    if (IN(7)) {
        PH_IDS
        pg8::Gemm g{XB, WinO, 1024, 1024, 1024, 0, 128, 12}; pg8::StaticOrder S; S.init(128, 12, G, blk);
        LAS float* rst = (LAS float*)(lds + 139264);
        { pg8::Unit pu; for (int i = 0; S.next(i, pu); ++i) if (tid < 256) rst[i * 256 + tid] = row_rstd(SSQ + 2 * SSQ_STRIDE, pu.pm * 256 + tid);
          __syncthreads(); }
        EpiIn1 E{rst, Qb, Kb, VT, Rb};
        pg8::gemm_phase<EpiIn1, false>(lds, g, S, E);
    }
    SEAM(7);
    if (IN(8)) {
        PH_IDS
        for (int bc = blk; bc < M / 64; bc += G) {
            const int hd = tid;
            float wa[16];
#pragma unroll
            for (int r = 0; r < 16; ++r) wa[r] = gla_w_a2[r * 512 + hd];
            const float ba = gla_b_a[hd];
            LAS float* cums = (LAS float*)lds + hd; float cum = 0.f;
            unsigned short kraw[64];
#pragma unroll
            for (int s = 0; s < 64; ++s) kraw[s] = Kb[(size_t)(bc * 64 + s) * 512 + hd];
            LAS float* al = (LAS float*)(lds + 131072);
            {
                LAS float* part = (LAS float*)(lds + 135168);
                const int c16 = lane & 15, kq = lane >> 4, rt = wave & 3, kh = wave >> 2;
                const bf16_t* ap = XB + (size_t)(bc * 64 + 16 * rt + c16) * 1024 + kh * 512 + 8 * kq;
                const int kb0 = kh * 512 + 8 * kq;
                f32x4 aacc = (f32x4){0.f, 0.f, 0.f, 0.f};
#pragma unroll 4
                for (int ks = 0; ks < 16; ++ks) aacc = __builtin_amdgcn_mfma_f32_16x16x32_bf16(*(const bf16x8*)(ap + 32 * ks), *(const bf16x8*)(WinO + pg8::bimg_off(3072 + c16, kb0 + 32 * ks, 16)), aacc, 0, 0, 0);
#pragma unroll
                for (int i = 0; i < 4; ++i) part[kh * 1024 + (16 * rt + 4 * kq + i) * 16 + c16] = aacc[i];
                __syncthreads();
                for (int idx = tid; idx < 1024; idx += 512) al[idx] = (part[idx] + part[1024 + idx]) * row_rstd(SSQ + 2 * SSQ_STRIDE, bc * 64 + (idx >> 4));
                __syncthreads();
            }
#pragma unroll 4
            for (int s = 0; s < 64; ++s) {
                const f32x4 a0 = *(const LAS f32x4*)(al + s * 16), a1 = *(const LAS f32x4*)(al + s * 16 + 4), a2 = *(const LAS f32x4*)(al + s * 16 + 8), a3 = *(const LAS f32x4*)(al + s * 16 + 12);
                float gl = ba;
                gl += a0[0] * wa[0] + a0[1] * wa[1] + a0[2] * wa[2] + a0[3] * wa[3];
                gl += a1[0] * wa[4] + a1[1] * wa[5] + a1[2] * wa[6] + a1[3] * wa[7];
                gl += a2[0] * wa[8] + a2[1] * wa[9] + a2[2] * wa[10] + a2[3] * wa[11];
                gl += a3[0] * wa[12] + a3[1] * wa[13] + a3[2] * wa[14] + a3[3] * wa[15];
                const float sp = fmaxf(-gl, 0.f) + LN2 * __builtin_amdgcn_logf(1.0f + __builtin_amdgcn_exp2f(-fabsf(gl) * LOG2E));
                cum -= sp * (1.0f / 16.0f);
                cums[s * 512] = cum;
            }
            DEC[(size_t)bc * 512 + hd] = __builtin_amdgcn_exp2f(cum * LOG2E);
            const int b = bc >> 7, c = bc & 127, h = hd >> 7, dk = hd & 127;
            bf16_t* dst = KDT + ((((size_t)(b * 4 + h) * 128 + c) * 8 + (dk >> 4)) * 128 + (dk & 15)) * 8;
#pragma unroll
            for (int s8 = 0; s8 < 8; ++s8) {
                float kd[8];
#pragma unroll
                for (int j = 0; j < 8; ++j) { const int s = s8 * 8 + j;
                    kd[j] = bf2f(kraw[s]) * __builtin_amdgcn_exp2f((cum - cums[s * 512]) * LOG2E); }
                u32x4 o; o.x = cvt_pk_bf16(kd[0], kd[1]); o.y = cvt_pk_bf16(kd[2], kd[3]); o.z = cvt_pk_bf16(kd[4], kd[5]); o.w = cvt_pk_bf16(kd[6], kd[7]);
                *(u32x4*)(dst + (s8 >> 2) * 512 + (s8 & 3) * 128) = o;
            }
            __syncthreads();
        }
    }
    SEAM(8);
    if (IN(9)) {
        PH_IDS
        for (int jb = blk; jb < 16 * (16 / P9_NCT); jb += G) {
            constexpr int JPB = 16 / P9_NCT;
            const int idx = jb >> 3, bh = 2 * (jb & 7) + idx / JPB, dvs = idx % JPB;
            const int b = bh >> 2, h = bh & 3;
            const int c16 = lane & 15, kq = lane >> 4;
            const bf16_t* kap = KDT + (size_t)(b * 4 + h) * 128 * 8192 + wave * 1024 + lane * 8;
            const bf16_t* vbp = VT + (size_t)(b * 4 + h) * 128 * 16384 + dvs * P9_NCT * 1024 + lane * 8;
            const float* dcp = DEC + (size_t)(b * 128) * 512 + h * 128 + 16 * wave + 4 * kq;
            const bf16_t* qap = Qb + (size_t)(b * 4 + h) * 128 * 8192 + (wave & 3) * 2048 + lane * 8;
            bf16_t* op = Ob + ((size_t)b * SEQ + 16 * (wave & 3) + 4 * kq) * 1024 + h * 256 + dvs * 16 * P9_NCT + c16;
            if (wave < 4) p9_job<true>(lds, kap, vbp, dcp, qap, op, wave, c16, kq);
            else p9_job<false>(lds, kap, vbp, dcp, qap, op, wave, c16, kq);
            __syncthreads();
        }
    }
    SEAM(9);
    if (IN(10)) {
        PH_IDS
        const int sub = lane & 15;
        f32x4 gn[4];
#pragma unroll
        for (int i = 0; i < 4; ++i) gn[i] = *(const f32x4*)(gla_o_gain + sub * 16 + 4 * i);
        u32x4 nv[4];
        { const size_t off0 = (size_t)gw * 1024 + lane * 16;
          nv[0] = *(const u32x4*)(Ob + off0); nv[1] = *(const u32x4*)(Ob + off0 + 8); nv[2] = *(const u32x4*)(Rb + off0); nv[3] = *(const u32x4*)(Rb + off0 + 8); }
        for (int t = gw; t < M; t += NGW) {
            const size_t off = (size_t)t * 1024 + lane * 16;
            const u32x4 ov0 = nv[0], ov1 = nv[1], rv0 = nv[2], rv1 = nv[3];
            { const int tn = t + NGW < M ? t + NGW : t; const size_t offn = (size_t)tn * 1024 + lane * 16;
              nv[0] = *(const u32x4*)(Ob + offn); nv[1] = *(const u32x4*)(Ob + offn + 8); nv[2] = *(const u32x4*)(Rb + offn); nv[3] = *(const u32x4*)(Rb + offn + 8); }
            float o[16], r[16];
#pragma unroll
            for (int i = 0; i < 4; ++i) {
                o[2 * i] = __builtin_bit_cast(float, ov0[i] << 16); o[2 * i + 1] = __builtin_bit_cast(float, ov0[i] & 0xffff0000u);
                o[8 + 2 * i] = __builtin_bit_cast(float, ov1[i] << 16); o[8 + 2 * i + 1] = __builtin_bit_cast(float, ov1[i] & 0xffff0000u);
                r[2 * i] = __builtin_bit_cast(float, rv0[i] << 16); r[2 * i + 1] = __builtin_bit_cast(float, rv0[i] & 0xffff0000u);
                r[8 + 2 * i] = __builtin_bit_cast(float, rv1[i] << 16); r[8 + 2 * i + 1] = __builtin_bit_cast(float, rv1[i] & 0xffff0000u);
            }
            float ss = 0.f;
#pragma unroll
            for (int i = 0; i < 16; ++i) ss += o[i] * o[i];
            ss += __shfl_xor(ss, 1); ss += __shfl_xor(ss, 2); ss += __shfl_xor(ss, 4); ss += __shfl_xor(ss, 8);
            const float rs = rsqrtf(ss * (1.0f / 256.0f) + EPS);
            float y[16];
#pragma unroll
            for (int i = 0; i < 16; ++i) { const float sg = r[i] * __builtin_amdgcn_rcpf(1.0f + __builtin_amdgcn_exp2f(-r[i] * LOG2E)); y[i] = o[i] * rs * gn[i >> 2][i & 3] * sg; }
            u32x4 w0, w1;
#pragma unroll
            for (int i = 0; i < 4; ++i) { w0[i] = cvt_pk_bf16(y[2 * i], y[2 * i + 1]); w1[i] = cvt_pk_bf16(y[8 + 2 * i], y[8 + 2 * i + 1]); }
            *(u32x4*)(MIX + off) = w0; *(u32x4*)(MIX + off + 8) = w1;
        }
    }
    SEAM(10);
    if (IN(11)) {
        PH_IDS
        pg8::Gemm g{MIX, WoutO, 1024, 1024, 1024, 0, 128, 4}; pg8::StaticOrder S; S.init(128, 4, G, blk);
        EpiRes<false> E{XB, out, SSQ + 3 * SSQ_STRIDE};
        pg8::gemm_phase<EpiRes<false>, false>(lds, g, S, E);
    }
    SEAM(11);
    if (IN(12)) {
        PH_IDS
        pg8::Gemm g{XB, Wup + (size_t)FF2 * 1024, 1024, 1024, 1024, 0, 128, 22}; pg8::StaticOrder S; S.init(128, 22, G, blk);
        LAS float* rst = (LAS float*)(lds + 139264);
        { pg8::Unit pu; for (int i = 0; S.next(i, pu); ++i) if (tid < 256) rst[i * 256 + tid] = row_rstd(SSQ + 3 * SSQ_STRIDE, pu.pm * 256 + tid);
          __syncthreads(); }
        EpiFfn2 E{rst, ffn_conv_w + 3 * FF2, ffn_conv_b + FF2, ACT, (float*)(ws + WS_UH), (float*)(ws + WS_UT), (LAS float*)(lds + 131072)};
        pg8::gemm_phase<EpiFfn2, false>(lds, g, S, E);
    }
    SEAM(12);
    if (IN(13)) {
        PH_IDS
        pg8::Gemm g{ACT, Wdn + (size_t)1024 * FF, FF, FF, FF, 0, 128, 4}; pg8::StaticOrder S; S.init(128, 4, G, blk);
        { pg8::Unit pu; for (int i = 0; S.next(i, pu); ++i) ffn_fixup(pu.pm, (const float*)(ws + WS_UH), (const float*)(ws + WS_UT), ffn_conv_w + 3 * FF2, ffn_conv_b + FF2, ACT, tid);
          asm volatile("s_waitcnt vmcnt(0)" ::: "memory"); __syncthreads(); }
        EpiRes<true> E{XB, out, SSQ};
        pg8::gemm_phase<EpiRes<true>, true>(lds, g, S, E);
    }
#undef IN
#undef SEAM
#undef ws
#undef x_in
#undef out
}


extern "C" void kernel_launch(void* const* d_in, const int* in_sizes, int n_in, void* d_out, int out_size, void* d_ws, size_t ws_size, hipStream_t stream) {
    static int grid = 0;
    if (grid == 0) {
        if (n_in != 19 || ws_size < WS_END) { fprintf(stderr, "kernel_launch: unexpected n_in %d / ws %zu\n", n_in, ws_size); grid = -1; return; }
        int dev = 0, cus = 0, per_cu = 0;
        hipGetDevice(&dev);
        hipDeviceGetAttribute(&cus, hipDeviceAttributeMultiprocessorCount, dev);
        if (hipFuncSetAttribute((const void*)hybrid_fwd, hipFuncAttributeMaxDynamicSharedMemorySize, LDS_BYTES) != hipSuccess) { fprintf(stderr, "kernel_launch: hipFuncSetAttribute failed\n"); grid = -1; return; }
        if (hipOccupancyMaxActiveBlocksPerMultiprocessor(&per_cu, (const void*)hybrid_fwd, 512, LDS_BYTES) != hipSuccess || per_cu < 1) { fprintf(stderr, "kernel_launch: occupancy query says %d\n", per_cu); per_cu = 1; }
        (void)hipGetLastError();
        grid = cus;
        if (grid != 256) fprintf(stderr, "kernel_launch: note: %d CUs\n", grid);
    }
    if (grid < 0) return;
    Args a{};
    for (int i = 0; i < 19; ++i) a.in[i] = (const float*)d_in[i];
    a.out = (float*)d_out; a.ws = (unsigned char*)d_ws;
#if MK_SINGLE
    a.ph_lo = 0; a.ph_hi = N_PHASES;
    if (hipMemsetAsync(d_ws, 0, 65536, stream) != hipSuccess) { fprintf(stderr, "kernel_launch: hipMemsetAsync failed\n"); return; }
    void* kargs[] = {&a};
    hipError_t e = hipLaunchCooperativeKernel((const void*)hybrid_fwd, dim3(grid), dim3(512), kargs, LDS_BYTES, stream);
    if (e != hipSuccess) fprintf(stderr, "cooperative launch failed: %s (grid %d)\n", hipGetErrorString(e), grid);
#else
#ifndef MAXPH
#define MAXPH N_PHASES
#endif
    for (int p = 0; p < MAXPH; ++p) {
        a.ph_lo = p; a.ph_hi = p + 1;
        hipLaunchKernelGGL(hybrid_fwd, dim3(grid), dim3(512), LDS_BYTES, stream, a);
    }

#endif
}
```

```cpp
#include <hip/hip_runtime.h>
#include <hip/hip_cooperative_groups.h>
#include <cstdio>
#include <cstdint>
namespace cg = cooperative_groups;

#ifndef MK_SINGLE
#define MK_SINGLE 1
#endif

#define LAS __attribute__((address_space(3)))
typedef unsigned short bf16_t;
typedef short bf16x8 __attribute__((ext_vector_type(8)));
typedef float f32x4 __attribute__((ext_vector_type(4)));
typedef float f32x16 __attribute__((ext_vector_type(16)));
typedef unsigned u32x4 __attribute__((ext_vector_type(4)));
typedef unsigned u32x2 __attribute__((ext_vector_type(2)));

constexpr int DM = 1024, NB = 4, SEQ = 8192, M = NB * SEQ;
constexpr int FF = 2816, FF2 = 5632;
constexpr float EPS = 1e-6f;
constexpr float LOG2E = 1.4426950408889634f, LN2 = 0.6931471805599453f;

typedef float f32x2_t __attribute__((ext_vector_type(2))); typedef __bf16 bf16x2_t __attribute__((ext_vector_type(2)));
__device__ __forceinline__ unsigned cvt_pk_bf16(float lo, float hi) { f32x2_t v = {lo, hi}; bf16x2_t b = __builtin_convertvector(v, bf16x2_t); return __builtin_bit_cast(unsigned, b); }
__device__ __forceinline__ unsigned f2bf(float f) { unsigned u = __builtin_bit_cast(unsigned, f); return (u + 0x7fffu + ((u >> 16) & 1u)) >> 16; }
__device__ __forceinline__ float bf2f(unsigned short h) { return __builtin_bit_cast(float, (unsigned)h << 16); }
__device__ __forceinline__ u32x4 pack8(f32x4 a, f32x4 b) { u32x4 w; w.x = cvt_pk_bf16(a[0], a[1]); w.y = cvt_pk_bf16(a[2], a[3]); w.z = cvt_pk_bf16(b[0], b[1]); w.w = cvt_pk_bf16(b[2], b[3]); return w; }
__device__ __forceinline__ float row_rstd(const float* ssq, int row) {
    const f32x4* p = (const f32x4*)(ssq + (size_t)row * 16);
    const f32x4 a = p[0], b = p[1], c = p[2], d = p[3];
    const float s = ((a[0] + a[1]) + (a[2] + a[3])) + ((b[0] + b[1]) + (b[2] + b[3])) + ((c[0] + c[1]) + (c[2] + c[3])) + ((d[0] + d[1]) + (d[2] + d[3]));
    return rsqrtf(s * (1.0f / 1024.0f) + EPS);
}
template <int CTRL> __device__ __forceinline__ float dpp0(float v) {
    return __builtin_bit_cast(float, __builtin_amdgcn_update_dpp(0, __builtin_bit_cast(int, v), CTRL, 0xf, 0xf, true));
}

namespace pg8 {
constexpr int BM = 256, BK = 64, HALF = 128, HTB = HALF * BK * 2, STAGE_BYTES = 8 * HTB, NXCD = 8, WGM = 8;
__host__ __device__ __forceinline__ int lds_byte(int r, int c) { const int st = (r >> 4) * 2 + (c >> 5), rr = r & 15, cc = c & 31, ob = rr * 64 + cc * 2; return st * 1024 + (ob ^ (((ob >> 9) & 1) << 5)); }
__host__ __device__ __forceinline__ void stage_rc(int b, int& R, int& C) { const int st = b / 1024, sb = b % 1024, swz = sb ^ (((sb >> 9) & 1) << 5); R = (st >> 1) * 16 + swz / 64; C = (st & 1) * 32 + (swz % 64) / 2; }
__host__ __device__ __forceinline__ int perm32(int rho) { const int n = rho >> 4, i = rho & 15; return 8 * (i >> 2) + 4 * n + (i & 3); }

struct Unit { int pm, pn, idx; };
__host__ __device__ __forceinline__ size_t bimg_off(int n, int k, int nkt) {
    const int n2 = n & 127, x = n2 & 31, rho = 16 * ((x >> 2) & 1) + 4 * (x >> 3) + (x & 3), R = (n2 & ~31) + rho;
    return ((size_t)((n >> 8) * nkt + (k >> 6)) * 2 + ((n >> 7) & 1)) * 8192 + (size_t)(lds_byte(R, k & 63) >> 1);
}
__host__ __device__ __forceinline__ size_t aimg_off(int row, int col, int nkt) {
    return ((size_t)((row >> 8) * nkt + (col >> 6)) * 2 + ((row >> 7) & 1)) * 8192 + (size_t)(lds_byte(row & 127, col & 63) >> 1);
}
struct Gemm { const bf16_t* A; const bf16_t* Bt; int lda, ldb, K, a_pn_off, nM, nN; };

struct StaticOrder {
    int nM, nN, nwg, G, c;
    __device__ __forceinline__ void init(int nM_, int nN_, int G_, int c_) { nM = nM_; nN = nN_; nwg = nM * nN; G = G_; c = c_; }
    __device__ __forceinline__ bool next(int i, Unit& u) const {
        const long L = (long)i * G + c; if (L >= nwg) return false;
        int wgid = (int)L; { const int q = nwg / NXCD, r = nwg % NXCD, xcd = wgid % NXCD, off = wgid / NXCD; wgid = (xcd < r ? xcd * (q + 1) : r * (q + 1) + (xcd - r) * q) + off; }
        const int nig = WGM * nN, gid = wgid / nig, fm = gid * WGM, gsz = (nM - fm) < WGM ? (nM - fm) : WGM;
        u.pm = fm + ((wgid % nig) % gsz); u.pn = (wgid % nig) / gsz; u.idx = i; return true;
    }
};

template <class Epi, bool HALO>
__device__ __forceinline__ void gemm_phase(LAS unsigned char* lds, const Gemm g, const StaticOrder& S, const Epi& E) {
    int tid = threadIdx.x; asm volatile("" : "+v"(tid));
    const int wid = __builtin_amdgcn_readfirstlane(tid >> 6), lane = tid & 63, wr = wid >> 2, wc = wid & 3, fr = lane & 15, fq = lane >> 4;
    const int K = g.K, nt = K / BK;
    unsigned voffA[2], voffB[2];
#pragma unroll
    for (int i = 0; i < 2; ++i) { int R, C; stage_rc(tid * 16 + i * 8192, R, C); const int Rb = (R & ~31) + perm32(R & 31);
        (void)Rb; voffA[i] = HALO ? (unsigned)(tid * 16 + i * 8192) : (unsigned)(R * g.lda + C) * 2u; voffB[i] = (unsigned)(tid * 16 + i * 8192); }
    const size_t kstep = HALO ? (size_t)2 * HTB : (size_t)(BK * 2), kstepB = (size_t)2 * HTB;
    const size_t hstepA = HALO ? (size_t)HTB : (size_t)128 * g.lda * 2, hstepB = (size_t)HTB;
    const size_t tstepA = HALO ? (size_t)nt * 2 * HTB : (size_t)256 * g.lda * 2, tstepB = (size_t)nt * 2 * HTB;
    const char* A0 = (const char*)g.A;
    const unsigned ldsw = (unsigned)wid * 1024u;
    const int aoff = lds_byte(wr * 64 + fr, fq * 8), boff = lds_byte(wc * 32 + fr, fq * 8);
#define PG8_SA(b, h) (((b) * 2 + (h)) * HTB)
#define PG8_SB(b, h) ((4 + (b) * 2 + (h)) * HTB)
#define PG8_STAGE(bufoff, gbase, voff) do { _Pragma("unroll") for (int _i = 0; _i < 2; ++_i) \
        __builtin_amdgcn_global_load_lds((const unsigned*)((const char*)(gbase) + (voff)[_i]), (LAS unsigned*)(lds + (bufoff) + ldsw + _i * 8192), 16, 0, 0); } while (0)
#define PG8_LDA(dst, b, h) do { _Pragma("unroll") for (int m = 0; m < 4; ++m) _Pragma("unroll") for (int k = 0; k < 2; ++k) dst[m][k] = *(const LAS bf16x8*)(lds + PG8_SA(b, h) + aoff + m * 2048 + k * 1024); } while (0)
#define PG8_LDB(dst, b, h) do { _Pragma("unroll") for (int n = 0; n < 2; ++n) _Pragma("unroll") for (int k = 0; k < 2; ++k) dst[n][k] = *(const LAS bf16x8*)(lds + PG8_SB(b, h) + boff + n * 2048 + k * 1024); } while (0)
#define PG8_MMA(ai, bj, At, Bt) do { __builtin_amdgcn_s_setprio(1); _Pragma("unroll") for (int m = 0; m < 4; ++m) _Pragma("unroll") for (int n = 0; n < 2; ++n) _Pragma("unroll") for (int k = 0; k < 2; ++k) \
        acc[ai][bj][m][n] = __builtin_amdgcn_mfma_f32_16x16x32_bf16(Bt[n][k], At[m][k], acc[ai][bj][m][n], 0, 0, 0); __builtin_amdgcn_s_setprio(0); } while (0)
#define PG8_WAIT_V(n) asm volatile("s_waitcnt vmcnt(" #n ")" ::: "memory")
#define PG8_WAIT_L(n) asm volatile("s_waitcnt lgkmcnt(" #n ")" ::: "memory")
#define PG8_BAR __builtin_amdgcn_s_barrier()
#define PG8_SCHED __builtin_amdgcn_sched_barrier(0)
    Unit cur, nxt; int ui = 0;
    if (!S.next(0, cur)) return;
    f32x4 acc[2][2][4][2];
#pragma unroll
    for (int a = 0; a < 2; ++a)
#pragma unroll
        for (int b = 0; b < 2; ++b)
#pragma unroll
            for (int m = 0; m < 4; ++m)
#pragma unroll
                for (int n = 0; n < 2; ++n) acc[a][b][m][n] = (f32x4){0.f, 0.f, 0.f, 0.f};
    bf16x8 At[4][2], B0[2][2], B1[2][2];
    const char* cA = A0 + (size_t)cur.pm * tstepA + (size_t)cur.pn * g.a_pn_off * 2; const char* cB = (const char*)g.Bt + (size_t)cur.pn * tstepB;
    PG8_STAGE(PG8_SB(0, 0), cB, voffB); PG8_STAGE(PG8_SB(0, 1), cB + hstepB, voffB); PG8_STAGE(PG8_SA(0, 0), cA, voffA); PG8_STAGE(PG8_SA(0, 1), cA + hstepA, voffA);
    if (wr == 1) PG8_BAR;
    PG8_WAIT_V(2); PG8_BAR;
    PG8_STAGE(PG8_SB(1, 0), cB + kstepB, voffB); PG8_STAGE(PG8_SA(1, 0), cA + kstep, voffA); PG8_STAGE(PG8_SB(1, 1), cB + hstepB + kstepB, voffB);
    PG8_WAIT_V(6); PG8_BAR;
    for (;;) {
        const bool has_next = S.next(ui + 1, nxt);
        const char* nA = has_next ? A0 + (size_t)nxt.pm * tstepA + (size_t)nxt.pn * g.a_pn_off * 2 : cA; const char* nB = has_next ? (const char*)g.Bt + (size_t)nxt.pn * tstepB : cB;
        for (int t = 0; t < nt; t += 2) {
            const bool last = (t == nt - 2);
            const char* a1 = cA + (size_t)(t + 1) * kstep;
            const char* a2 = last ? nA : cA + (size_t)(t + 2) * kstep; const char* b2 = last ? nB : cB + (size_t)(t + 2) * kstepB;
            const char* a3 = a2 + kstep; const char* b3 = b2 + kstepB;
            PG8_LDB(B0, 0, 0); PG8_LDB(B1, 0, 1); PG8_SCHED; PG8_LDA(At, 0, 0); PG8_STAGE(PG8_SA(1, 1), a1 + hstepA, voffA);
            PG8_WAIT_V(8); PG8_WAIT_L(0); PG8_BAR; PG8_MMA(0, 0, At, B0); PG8_MMA(0, 1, At, B1); PG8_BAR; PG8_SCHED;
            PG8_LDA(At, 0, 1); PG8_STAGE(PG8_SB(0, 0), b2, voffB); PG8_STAGE(PG8_SB(0, 1), b2 + hstepB, voffB); PG8_STAGE(PG8_SA(0, 0), a2, voffA);
            PG8_WAIT_V(8); PG8_WAIT_L(0); PG8_BAR; PG8_MMA(1, 0, At, B0); PG8_MMA(1, 1, At, B1); PG8_BAR; PG8_SCHED;
            PG8_LDB(B0, 1, 0); PG8_LDB(B1, 1, 1); PG8_SCHED; PG8_LDA(At, 1, 0); PG8_STAGE(PG8_SA(0, 1), a2 + hstepA, voffA);
            PG8_WAIT_V(8); PG8_WAIT_L(0); PG8_BAR; PG8_MMA(0, 0, At, B0); PG8_MMA(0, 1, At, B1); PG8_BAR; PG8_SCHED;
            PG8_LDA(At, 1, 1); PG8_STAGE(PG8_SB(1, 0), b3, voffB); PG8_STAGE(PG8_SB(1, 1), b3 + hstepB, voffB); PG8_STAGE(PG8_SA(1, 0), a3, voffA);
            PG8_WAIT_V(8); PG8_WAIT_L(0); PG8_BAR; PG8_MMA(1, 0, At, B0); PG8_MMA(1, 1, At, B1); PG8_BAR; PG8_SCHED;
        }
        if (wr == 0) PG8_BAR;
        { int l_ = threadIdx.x, wr_ = wr, wc_ = wc;
          asm volatile("" : "+v"(l_), "+s"(wr_), "+s"(wc_));
          E(acc, cur, wr_, wc_, l_ & 15, (l_ >> 4) & 3); }
        if (!has_next) break;
#pragma unroll
        for (int a = 0; a < 2; ++a)
#pragma unroll
            for (int b = 0; b < 2; ++b)
#pragma unroll
                for (int m = 0; m < 4; ++m)
#pragma unroll
                    for (int n = 0; n < 2; ++n) acc[a][b][m][n] = (f32x4){0.f, 0.f, 0.f, 0.f};
        cur = nxt; cA = nA; cB = nB; ++ui;
        if (wr == 1) PG8_BAR;
    }
    PG8_WAIT_V(0);
    PG8_BAR;
#undef PG8_SA
#undef PG8_SB
#undef PG8_STAGE
#undef PG8_LDA
#undef PG8_LDB
#undef PG8_MMA
#undef PG8_WAIT_V
#undef PG8_WAIT_L
#undef PG8_BAR
#undef PG8_SCHED
}
}
typedef f32x4 AccT[2][2][4][2];

struct EpiIn0 {
    const LAS float* rst; const float* qg; const float* kg; bf16_t* Q; bf16_t* Kb; bf16_t* VT; bf16_t* XP;
    __device__ __forceinline__ void operator()(const AccT& acc, const pg8::Unit& u, int wr, int wc, int fr, int fq) const {
        const int pn = u.pn;
        if (pn < 4) {
            const LAS float* gp = rst + 4096 + (pn < 2 ? 0 : 64);
            f32x4 gv[2][2];
#pragma unroll
            for (int bj = 0; bj < 2; ++bj)
#pragma unroll
                for (int n = 0; n < 2; ++n) gv[bj][n] = *(const LAS f32x4*)(gp + 32 * bj + 8 * fq + 4 * n);
            bf16_t* dst = (pn < 2 ? Q : Kb) + (size_t)((pn & 1) * 4 + wc) * 8192 * 64 + 8 * fq;
            const float sc = (pn < 2) ? 0.125f * LOG2E : 1.0f;
#pragma unroll
            for (int ai = 0; ai < 2; ++ai)
#pragma unroll
                for (int m = 0; m < 4; ++m) {
                    const int row = u.pm * 256 + ai * 128 + wr * 64 + m * 16 + fr;
                    const float rs = rst[u.idx * 256 + ai * 128 + wr * 64 + m * 16 + fr];
                    f32x4 v[2][2]; float ss = 0.f;
#pragma unroll
                    for (int bj = 0; bj < 2; ++bj)
#pragma unroll
                        for (int n = 0; n < 2; ++n) { v[bj][n] = acc[ai][bj][m][n] * rs; const f32x4 x = v[bj][n]; ss += (x[0] * x[0] + x[1] * x[1]) + (x[2] * x[2] + x[3] * x[3]); }
                    ss += __shfl_xor(ss, 16); ss += __shfl_xor(ss, 32);
                    const float r2 = rsqrtf(ss * (1.0f / 64.0f) + EPS) * sc;
#pragma unroll
                    for (int bj = 0; bj < 2; ++bj) {
                        const f32x4 a = v[bj][0] * r2 * gv[bj][0], b = v[bj][1] * r2 * gv[bj][1];
                        if (pn < 2) *(u32x4*)(dst + ((size_t)(row >> 13) * 8 * 8192 + (row & 8191)) * 64 + 32 * bj) = pack8(a, b);
                        else {
                            const int sq = row & 8191, kap_ = sq & 31, rho = (kap_ & 3) + 4 * (kap_ >> 4) + 8 * ((kap_ & 15) >> 2);
                            *(u32x4*)(Kb + ((((size_t)((row >> 13) * 8 + (pn & 1) * 4 + wc) * 256 + (sq >> 5)) * 4 + 2 * bj + (fq >> 1)) * 64 + (fq & 1) * 32 + rho) * 8) = pack8(a, b);
                        }
                    }
                }
        } else if (pn < 6) {
#pragma unroll
            for (int ai = 0; ai < 2; ++ai)
#pragma unroll
                for (int m = 0; m < 4; ++m) {
                    const int row = u.pm * 256 + ai * 128 + wr * 64 + m * 16 + fr;
                    const float rs = rst[u.idx * 256 + ai * 128 + wr * 64 + m * 16 + fr];
                    const int b = row >> 13, s = row & 8191, head = (pn - 4) * 4 + wc;
                    const int kap_ = s & 31;
                    bf16_t* vt = VT + ((((size_t)(b * 8 + head) * 256 + (s >> 5)) * 4 + ((kap_ >> 3) & 1)) * 64 + (kap_ >> 4) * 32 + 8 * fq) * 8 + (kap_ & 7);
#pragma unroll
                    for (int bj = 0; bj < 2; ++bj)
#pragma unroll
                        for (int n = 0; n < 2; ++n)
#pragma unroll
                            for (int e = 0; e < 4; ++e) vt[bj * 1024 + (4 * n + e) * 8] = (bf16_t)f2bf(acc[ai][bj][m][n][e] * rs);
                }
        } else {
            bf16_t* dst = XP + (pn - 6) * 256 + 64 * wc + 8 * fq;
#pragma unroll
            for (int ai = 0; ai < 2; ++ai)
#pragma unroll
                for (int m = 0; m < 4; ++m) {
                    const int row = u.pm * 256 + ai * 128 + wr * 64 + m * 16 + fr;
                    const float rs = rst[u.idx * 256 + ai * 128 + wr * 64 + m * 16 + fr];
#pragma unroll
                    for (int bj = 0; bj < 2; ++bj)
                        *(u32x4*)(dst + (size_t)row * 512 + 32 * bj) = pack8(acc[ai][bj][m][0] * rs, acc[ai][bj][m][1] * rs);
                }
        }
    }
};
struct EpiIn1 {
    const LAS float* rst; bf16_t* Q; bf16_t* Kb; bf16_t* VT; bf16_t* R;
    __device__ __forceinline__ void operator()(const AccT& acc, const pg8::Unit& u, int wr, int wc, int fr, int fq) const {
        const int pn = u.pn;
#pragma unroll
        for (int ai = 0; ai < 2; ++ai)
#pragma unroll
            for (int m = 0; m < 4; ++m) {
                const int row = u.pm * 256 + ai * 128 + wr * 64 + m * 16 + fr;
                const float rs = rst[u.idx * 256 + ai * 128 + wr * 64 + m * 16 + fr];
                if (pn < 4) {
                    const float sc = (pn < 2) ? rs * 0.08838834764831845f : rs;
                    if (pn < 2) {
                        const int sq = row & 8191;
                        bf16_t* dst = Q + (((((size_t)((row >> 13) * 4 + 2 * pn) * 128 + (sq >> 6)) * 4 + ((sq >> 4) & 3)) * 4 + wc) * 64 + fq * 16 + (sq & 15)) * 8;
#pragma unroll
                        for (int bj = 0; bj < 2; ++bj) *(u32x4*)(dst + (size_t)bj * 8192 * 128) = pack8(acc[ai][bj][m][0] * sc, acc[ai][bj][m][1] * sc);
                    } else {
                        bf16_t* dst = Kb + (size_t)row * 512 + (pn & 1) * 256 + 32 * wc + 8 * fq;
#pragma unroll
                        for (int bj = 0; bj < 2; ++bj) *(u32x4*)(dst + 128 * bj) = pack8(acc[ai][bj][m][0] * sc, acc[ai][bj][m][1] * sc);
                    }
                } else if (pn < 8) {
                    const int b = row >> 13, s = row & 8191, h = pn - 4;
                    bf16_t* vt = VT + (((((size_t)(b * 4 + h) * 128 + (s >> 6)) * 16 + 2 * wc + (fq >> 1)) * 2 + ((s >> 5) & 1)) * 64 + ((s >> 3) & 3) * 16 + 8 * (fq & 1)) * 8 + (s & 7);
#pragma unroll
                    for (int bj = 0; bj < 2; ++bj)
#pragma unroll
                        for (int n = 0; n < 2; ++n)
#pragma unroll
                            for (int e = 0; e < 4; ++e) vt[bj * 8192 + (4 * n + e) * 8] = (bf16_t)f2bf(acc[ai][bj][m][n][e] * rs);
                } else {
                    bf16_t* dst = R + (size_t)row * 1024 + (pn - 8) * 256 + 32 * wc + 8 * fq;
#pragma unroll
                    for (int bj = 0; bj < 2; ++bj) *(u32x4*)(dst + 128 * bj) = pack8(acc[ai][bj][m][0] * rs, acc[ai][bj][m][1] * rs);
                }
            }
    }
};
template <bool LAST>
struct EpiRes {
    bf16_t* XB; float* out; float* ssq_out;
    __device__ __forceinline__ void operator()(const AccT& acc, const pg8::Unit& u, int wr, int wc, int fr, int fq) const {
#pragma unroll
        for (int ai = 0; ai < 2; ++ai)
#pragma unroll
            for (int m = 0; m < 4; ++m) {
                const int row = u.pm * 256 + ai * 128 + wr * 64 + m * 16 + fr;
                const size_t off = (size_t)row * 1024 + u.pn * 256 + 32 * wc + 8 * fq;
                float ss = 0.f;
#pragma unroll
                for (int bj = 0; bj < 2; ++bj) {
                    const u32x4 bv = *(const u32x4*)(XB + off + 128 * bj);
                    f32x4 b0, b1;
                    b0[0] = __builtin_bit_cast(float, bv[0] << 16); b0[1] = __builtin_bit_cast(float, bv[0] & 0xffff0000u); b0[2] = __builtin_bit_cast(float, bv[1] << 16); b0[3] = __builtin_bit_cast(float, bv[1] & 0xffff0000u);
                    b1[0] = __builtin_bit_cast(float, bv[2] << 16); b1[1] = __builtin_bit_cast(float, bv[2] & 0xffff0000u); b1[2] = __builtin_bit_cast(float, bv[3] << 16); b1[3] = __builtin_bit_cast(float, bv[3] & 0xffff0000u);
                    const f32x4 o0 = b0 + acc[ai][bj][m][0], o1 = b1 + acc[ai][bj][m][1];
                    if (LAST) { *(f32x4*)(out + off + 128 * bj) = o0; *(f32x4*)(out + off + 128 * bj + 4) = o1; }
                    else {
                        *(u32x4*)(XB + off + 128 * bj) = pack8(o0, o1);
                        ss += ((o0[0] * o0[0] + o0[1] * o0[1]) + (o0[2] * o0[2] + o0[3] * o0[3])) + ((o1[0] * o1[0] + o1[1] * o1[1]) + (o1[2] * o1[2] + o1[3] * o1[3]));
                    }
                }
                if (!LAST) {
                    ss += __shfl_xor(ss, 16); ss += __shfl_xor(ss, 32);
                    if (fq == 0) ssq_out[(size_t)row * 16 + u.pn * 4 + wc] = ss;
                }
            }
    }
};
struct EpiPool {
    const float* scale; bf16_t* MIX;
    __device__ __forceinline__ void operator()(const AccT& acc, const pg8::Unit& u, int wr, int wc, int fr, int fq) const {
        const int col0 = u.pn * 256 + 32 * wc + 8 * fq;
        f32x4 sv[2][2];
#pragma unroll
        for (int bj = 0; bj < 2; ++bj)
#pragma unroll
            for (int n = 0; n < 2; ++n) sv[bj][n] = *(const f32x4*)(scale + col0 + 128 * bj + 4 * n);
#pragma unroll
        for (int ai = 0; ai < 2; ++ai)
#pragma unroll
            for (int m = 0; m < 4; ++m) {
                const int row = u.pm * 256 + ai * 128 + wr * 64 + m * 16 + fr;
#pragma unroll
                for (int bj = 0; bj < 2; ++bj)
                    *(u32x4*)(MIX + (size_t)row * 1024 + 512 + col0 + 128 * bj) = pack8(acc[ai][bj][m][0] * sv[bj][0], acc[ai][bj][m][1] * sv[bj][1]);
            }
    }
};
struct EpiFfn2 {
    const LAS float* rst; const float* cw; const float* cb; bf16_t* ACT; float* UH; float* UT; LAS float* tl;
    __device__ __forceinline__ void operator()(AccT& acc, const pg8::Unit& u, int wr, int wc, int fr, int fq) const {
        const int f0 = u.pn * 128 + 32 * wc + 8 * fq, t0 = u.pm * 256, cl = 32 * wc + 8 * fq;
        const bool bstart = (t0 & 8191) == 0;
        LAS float* wt = tl + 6144;
        const int wt_t = (4 * wr + wc) * 64 + fq * 16 + fr;
        f32x4 wreg = (f32x4){0.f, 0.f, 0.f, 0.f};
        if (wt_t < 256) { const int kind = wt_t >> 6, hf = (wt_t & 63) >> 5, c = ((wt_t & 63) * 4) & 127;
            wreg = *(const f32x4*)((kind < 3 ? cw + kind * FF2 : cb) + hf * FF + u.pn * 128 + c); }
#pragma unroll
        for (int ai = 0; ai < 2; ++ai)
#pragma unroll
            for (int m = 0; m < 4; ++m) {
                const float rs = rst[u.idx * 256 + 128 * ai + 64 * wr + 16 * m + fr];
#pragma unroll
                for (int bj = 0; bj < 2; ++bj)
#pragma unroll
                    for (int n = 0; n < 2; ++n) acc[ai][bj][m][n] = acc[ai][bj][m][n] * rs;
            }
        if (fr >= 14) {
#pragma unroll
            for (int ai = 0; ai < 2; ++ai)
#pragma unroll
                for (int bj = 0; bj < 2; ++bj)
#pragma unroll
                    for (int n = 0; n < 2; ++n) *(LAS f32x4*)(tl + (((2 * ai + wr) * 2 + (fr - 14)) * 256 + 128 * bj + cl + 4 * n)) = acc[ai][bj][3][n];
            if (wr == 1) {
#pragma unroll
                for (int bj = 0; bj < 2; ++bj)
#pragma unroll
                    for (int n = 0; n < 2; ++n) *(f32x4*)(UT + (size_t)(u.pm * 2 + (fr - 14)) * FF2 + bj * FF + f0 + 4 * n) = acc[1][bj][3][n];
            }
        }
        if (wr == 0 && fr < 2) {
#pragma unroll
            for (int bj = 0; bj < 2; ++bj)
#pragma unroll
                for (int n = 0; n < 2; ++n) *(f32x4*)(UH + (size_t)(u.pm * 2 + fr) * FF2 + bj * FF + f0 + 4 * n) = acc[0][bj][0][n];
        }
        if (wt_t < 256) *(LAS f32x4*)(wt + 4 * wt_t) = wreg;
        asm volatile("s_waitcnt lgkmcnt(0)" ::: "memory"); __builtin_amdgcn_s_barrier(); asm volatile("" ::: "memory");
        bf16_t* abase = ACT + (size_t)(u.pm * (FF / 64) + 2 * u.pn + (wc >> 1)) * 16384 + (8 * wr + (wc & 1)) * 512 + (((fr * 64 + 16 * fq) ^ ((fr >> 3) << 5)) >> 1);
#pragma unroll
        for (int n = 0; n < 2; ++n) {
            asm volatile("" ::: "memory");
            f32x4 w0[2], w1[2], w2[2], bb[2];
#pragma unroll
            for (int bj = 0; bj < 2; ++bj) { const LAS float* wp = wt + bj * 128 + cl + 4 * n;
                w0[bj] = *(const LAS f32x4*)(wp); w1[bj] = *(const LAS f32x4*)(wp + 256); w2[bj] = *(const LAS f32x4*)(wp + 512); bb[bj] = *(const LAS f32x4*)(wp + 768); }
#pragma unroll
            for (int ai = 0; ai < 2; ++ai) {
                const int blk = 2 * ai + wr;
                f32x4 e1[2], e2[2];
#pragma unroll
                for (int bj = 0; bj < 2; ++bj) {
                    f32x4 v62 = (f32x4){0.f, 0.f, 0.f, 0.f}, v63 = v62;
                    if (blk > 0) { v62 = *(const LAS f32x4*)(tl + (((blk - 1) * 2 + 0) * 256 + 128 * bj + cl + 4 * n)); v63 = *(const LAS f32x4*)(tl + (((blk - 1) * 2 + 1) * 256 + 128 * bj + cl + 4 * n)); }
                    const f32x4 z = (f32x4){0.f, 0.f, 0.f, 0.f};
                    e1[bj] = (fr == 0) ? v63 : z; e2[bj] = (fr == 0) ? v62 : ((fr == 1) ? v63 : z); }
#pragma unroll
                for (int m = 0; m < 4; ++m) {
                    f32x4 cv[2];
#pragma unroll
                    for (int bj = 0; bj < 2; ++bj)
#pragma unroll
                        for (int e = 0; e < 4; ++e) {
                            const float cur = acc[ai][bj][m][n][e];
                            float p1 = dpp0<0x111>(cur), p2 = dpp0<0x112>(cur);
                            if (m > 0) { const float prv = acc[ai][bj][m - 1][n][e]; p1 += dpp0<0x10F>(prv); p2 += dpp0<0x10E>(prv); }
                            else { p1 += e1[bj][e]; p2 += e2[bj][e]; }
                            cv[bj][e] = bb[bj][e] + w2[bj][e] * cur + w1[bj][e] * p1 + w0[bj][e] * p2;
                        }
                    u32x2 w; float r[4];
#pragma unroll
                    for (int e = 0; e < 4; ++e) { const float a = cv[0][e]; r[e] = a * __builtin_amdgcn_rcpf(1.0f + __builtin_amdgcn_exp2f(-a * LOG2E)) * cv[1][e]; }
                    w.x = cvt_pk_bf16(r[0], r[1]); w.y = cvt_pk_bf16(r[2], r[3]);
                    const bool deferred = (blk == 0) && (m == 0) && (fr < 2) && !bstart;
                    if (!deferred) *(u32x2*)(abase + ai * 8192 + m * 1024 + n * 4) = w;
                }
            }
        }
    }
};
__device__ __forceinline__ void ffn_fixup(int pm, const float* __restrict__ UH, const float* __restrict__ UT, const float* __restrict__ cw, const float* __restrict__ cb, bf16_t* __restrict__ ACT, int tid) {
    if (((pm * 256) & 8191) == 0) return;
    for (int f = tid; f < FF; f += 512) {
        float cva[2], cvg[2];
#pragma unroll
        for (int hg = 0; hg < 2; ++hg) {
            const int ch = hg * FF + f;
            const float h0 = UH[(size_t)(pm * 2 + 0) * FF2 + ch], h1 = UH[(size_t)(pm * 2 + 1) * FF2 + ch];
            const float q2 = UT[(size_t)((pm - 1) * 2 + 0) * FF2 + ch], q1 = UT[(size_t)((pm - 1) * 2 + 1) * FF2 + ch];
            const float w0 = cw[ch], w1 = cw[FF2 + ch], w2 = cw[2 * FF2 + ch], bb = cb[ch];
            const float r0 = bb + w2 * h0 + w1 * q1 + w0 * q2, r1 = bb + w2 * h1 + w1 * h0 + w0 * q1;
            if (hg == 0) { cva[0] = r0; cva[1] = r1; } else { cvg[0] = r0; cvg[1] = r1; }
        }
#pragma unroll
        for (int r = 0; r < 2; ++r) { const float a = cva[r]; const float y = a * __builtin_amdgcn_rcpf(1.0f + __builtin_amdgcn_exp2f(-a * LOG2E)) * cvg[r];
            ACT[pg8::aimg_off(pm * 256 + r, f, FF / 64)] = (bf16_t)f2bf(y); }
    }
}

constexpr size_t MiB = 1u << 20;
constexpr size_t WS_WINE = 2 * MiB, WS_POOLW = 6 * MiB, WS_WOUTE = 7 * MiB, WS_WINO = 9 * MiB, WS_WOUTO = 16 * MiB, WS_WUP = 18 * MiB, WS_WDN = 40 * MiB;
constexpr size_t WS_SSQ = 52 * MiB;
constexpr size_t WS_DEC = 60 * MiB;
constexpr size_t WS_ALOW = 61 * MiB;
constexpr size_t WS_XB = 64 * MiB + 65536;
constexpr size_t WS_P0 = 130 * MiB;
constexpr size_t WS_Q = WS_P0, WS_K = WS_P0 + 32 * MiB, WS_VT = WS_P0 + 64 * MiB;
constexpr size_t WS_XP = WS_P0 + 96 * MiB;
constexpr size_t WS_R = WS_P0 + 128 * MiB;
constexpr size_t WS_MIX = 322 * MiB;
constexpr size_t WS_POOLED = 386 * MiB;
constexpr size_t WS_KDT = 386 * MiB, WS_O = 418 * MiB;
constexpr size_t WS_ACT = 130 * MiB;
constexpr size_t WS_UH = 482 * MiB, WS_UT = 490 * MiB;
constexpr size_t WS_END = 498 * MiB;

struct Args {
    const float* in[19]; float* out; unsigned char* ws; int ph_lo, ph_hi;
};
constexpr int N_PHASES = 14;
constexpr int LDS_BYTES = 163840;

#define XB_TMO      128
#define XB_XCNT(j)  (256  + 64 * (j))
#define XB_XSUB(j)  (1280 + 64 * (j))
#define XB_XGEN(j)  (2304 + 64 * (j))
#define XB_TOP      3328
#define XB_TOPGEN   3392
#define XCD_BAR_WORDS 3456
#define XB_SPIN_CAP (1u << 18)

__device__ __forceinline__ unsigned xb_ld(unsigned* p)              { return __hip_atomic_load(p, __ATOMIC_RELAXED, __HIP_MEMORY_SCOPE_AGENT); }
__device__ __forceinline__ unsigned xb_add(unsigned* p, unsigned v) { return __hip_atomic_fetch_add(p, v, __ATOMIC_RELAXED, __HIP_MEMORY_SCOPE_AGENT); }
__device__ __forceinline__ unsigned xb_xcc_id() { return (unsigned)__builtin_amdgcn_s_getreg((3 << 11) | 20) & 0xFu; }
#define XB_SPIN(cond, bar) do { unsigned _sp = 0; while (cond) { __builtin_amdgcn_s_sleep(1); \
    if ((++_sp & 255u) == 0u) { if (xb_ld(&(bar)[XB_TMO])) break; if (_sp > XB_SPIN_CAP) { atomicAdd(&(bar)[XB_TMO], 1u); break; } } } } while (0)

struct XcdBarrier {
    unsigned* bar; unsigned x;
    volatile LAS unsigned* st;
};

__device__ __forceinline__ XcdBarrier xcd_barrier_post(unsigned* bar, volatile LAS unsigned* st) {
    XcdBarrier b; b.bar = bar; b.x = xb_xcc_id(); b.st = st;
    if (threadIdx.x == 0) (void)xb_add(&bar[XB_XCNT(b.x)], 1u);
    return b;
}
__device__ __forceinline__ void xcd_barrier_complete(unsigned* bar, unsigned x, unsigned& nloc, unsigned& nx) {
    const unsigned G = gridDim.x * gridDim.y * gridDim.z;
    unsigned sum, cnt, mine, sp = 0u;
    for (;;) {
        sum = 0u; cnt = 0u; mine = 0u;
#pragma unroll
        for (unsigned j = 0; j < 16; ++j) { const unsigned c = xb_ld(&bar[XB_XCNT(j)]); sum += c; cnt += (c > 0u) ? 1u : 0u; mine = (j == x) ? c : mine; }
        if (sum == G) break;
        __builtin_amdgcn_s_sleep(1);
        if ((++sp & 255u) == 0u) { if (xb_ld(&bar[XB_TMO])) break; if (sp > XB_SPIN_CAP) { atomicAdd(&bar[XB_TMO], 1u); break; } }
    }
    nloc = mine > 0u ? mine : 1u; nx = cnt > 0u ? cnt : 1u;
}

__device__ __forceinline__ void xcd_barrier(const XcdBarrier& b) {
    asm volatile("s_waitcnt vmcnt(0)" ::: "memory");
    __syncthreads();
    if (threadIdx.x == 0) {
        unsigned* bar = b.bar;
        __builtin_amdgcn_s_waitcnt(0);
        unsigned nloc = b.st[0], nx = b.st[1];
        if (nloc == 0u) { xcd_barrier_complete(bar, b.x, nloc, nx); b.st[0] = nloc; b.st[1] = nx; }
        const unsigned old = xb_add(&bar[XB_XSUB(b.x)], 1u);
        const unsigned gen = old / nloc;
        if (old + 1u == (gen + 1u) * nloc) {
            __builtin_amdgcn_fence(__ATOMIC_RELEASE, "agent");
            asm volatile("s_waitcnt vmcnt(0)" ::: "memory");
            const unsigned og = xb_add(&bar[XB_TOP], 1u);
            const unsigned tg = og / nx;
            if (og + 1u == (tg + 1u) * nx) xb_add(&bar[XB_TOPGEN], 1u);
            else XB_SPIN(xb_ld(&bar[XB_TOPGEN]) == tg, bar);
            __builtin_amdgcn_fence(__ATOMIC_ACQUIRE, "agent");
            xb_add(&bar[XB_XGEN(b.x)], 1u);
            asm volatile("s_waitcnt vmcnt(0)" ::: "memory");
        } else {
            XB_SPIN(xb_ld(&bar[XB_TOPGEN]) == gen, bar);
            __builtin_amdgcn_fence(__ATOMIC_ACQUIRE, "agent");
            asm volatile("s_waitcnt vmcnt(0)" ::: "memory");
        }
    }
    __syncthreads();
}


__device__ __forceinline__ float wave_sum(float v) {
#pragma unroll
    for (int o = 1; o < 64; o <<= 1) v += __shfl_xor(v, o);
    return v;
}
struct MapId { __device__ __forceinline__ int operator()(int n) const { return n; } };
struct MapHead { __device__ __forceinline__ int operator()(int n) const { const int a = n & 255; return (n & ~255) + 128 * ((a & 63) >> 5) + 32 * (a >> 6) + (a & 31); } };
struct MapFfn { __device__ __forceinline__ int operator()(int n) const { const int half = n >= FF ? 1 : 0, f = n - half * FF; return 256 * (f >> 7) + 128 * half + (f & 127); } };

template <class RowMap>
__device__ __forceinline__ void transpose_item(const float* W, int K, int N, const float* gain, bf16_t* WT, RowMap rm, LAS float* scr, int item, int lane) {
    const int nblk = (N + 31) / 32, kb = item / nblk, nb = item % nblk, k0 = 64 * kb, n0 = 32 * nb;
    const int nn = n0 + (lane & 31);
    float tv[32];
#pragma unroll
    for (int i = 0; i < 32; ++i) { const int kk = 2 * i + (lane >> 5); tv[i] = (nn < N) ? W[(size_t)(k0 + kk) * N + nn] : 0.f; }
    if (gain) {
#pragma unroll
        for (int i = 0; i < 32; ++i) tv[i] *= gain[k0 + 2 * i + (lane >> 5)];
    }
#pragma unroll
    for (int i = 0; i < 32; ++i) scr[(2 * i + (lane >> 5)) * 33 + (lane & 31)] = tv[i];
    asm volatile("s_waitcnt lgkmcnt(0)" ::: "memory");
    const int c = lane & 7;
#pragma unroll
    for (int j = 0; j < 4; ++j) { const int nl = (lane >> 3) + 8 * j; const LAS float* s = scr + (8 * c) * 33 + nl;
        u32x4 o; o.x = cvt_pk_bf16(s[0 * 33], s[1 * 33]); o.y = cvt_pk_bf16(s[2 * 33], s[3 * 33]); o.z = cvt_pk_bf16(s[4 * 33], s[5 * 33]); o.w = cvt_pk_bf16(s[6 * 33], s[7 * 33]);
        if (n0 + nl < N) *(u32x4*)(WT + pg8::bimg_off(rm(n0 + nl), k0 + 8 * c, K / 64)) = o; }
    asm volatile("s_waitcnt lgkmcnt(0)" ::: "memory");
}

template <bool DIAG>
__device__ __forceinline__ void sb_tile(const bf16x8 (&kf)[4], const bf16x8 (&vf)[4], const bf16x8 (&qf)[4], f32x16& o0, f32x16& o1, float& c, int rel0, int hi) {
    f32x16 s;
#pragma unroll
    for (int r = 0; r < 16; ++r) s[r] = 0.f;
#pragma unroll
    for (int d0 = 0; d0 < 4; ++d0) s = __builtin_amdgcn_mfma_f32_32x32x16_bf16(kf[d0], qf[d0], s, 0, 0, 0);
    float L[16]; float tot = 0.f;
#pragma unroll
    for (int r = 15; r >= 0; --r) {
        const float z = s[r];
        const float sp = fmaxf(z, 0.f) + __builtin_amdgcn_logf(1.0f + __builtin_amdgcn_exp2f(-fabsf(z)));
        if (DIAG) tot += (r < rel0) ? -sp : 0.f; else tot -= sp;
        L[r] = tot;
    }
    const float tot_o = __shfl_xor(tot, 32);
    const float add = c + (hi == 0 ? tot_o : 0.f);
    float w[16];
#pragma unroll
    for (int r = 0; r < 16; ++r) {
        const float e = __builtin_amdgcn_exp2f(s[r] + L[r] + add);
        w[r] = DIAG ? ((r < rel0) ? e : 0.f) : e;
    }
    c += tot + tot_o;
    u32x4 p0, p1;
    p0.x = cvt_pk_bf16(w[0], w[1]); p0.y = cvt_pk_bf16(w[2], w[3]); p0.z = cvt_pk_bf16(w[4], w[5]); p0.w = cvt_pk_bf16(w[6], w[7]);
    p1.x = cvt_pk_bf16(w[8], w[9]); p1.y = cvt_pk_bf16(w[10], w[11]); p1.z = cvt_pk_bf16(w[12], w[13]); p1.w = cvt_pk_bf16(w[14], w[15]);
    const bf16x8 pf0 = __builtin_bit_cast(bf16x8, p0), pf1 = __builtin_bit_cast(bf16x8, p1);
    o0 = __builtin_amdgcn_mfma_f32_32x32x16_bf16(vf[0], pf0, o0, 0, 0, 0);
    o0 = __builtin_amdgcn_mfma_f32_32x32x16_bf16(vf[1], pf1, o0, 0, 0, 0);
    o1 = __builtin_amdgcn_mfma_f32_32x32x16_bf16(vf[2], pf0, o1, 0, 0, 0);
    o1 = __builtin_amdgcn_mfma_f32_32x32x16_bf16(vf[3], pf1, o1, 0, 0, 0);
}
__device__ __forceinline__ void sb_attn_unit(const bf16_t* __restrict__ Q, const bf16_t* __restrict__ Kb, const bf16_t* __restrict__ VT, bf16_t* __restrict__ MIX, int b, int h, int qb, int lane) {
    const int q = lane & 31, hi = lane >> 5, q0 = qb * 32;
    const size_t rowbase = (size_t)b * SEQ;
    bf16x8 qf[4];
    const size_t hb = (size_t)(b * 8 + h) * 8192;
    { const bf16_t* qp = Q + (hb + q0 + q) * 64 + 8 * hi;
#pragma unroll
      for (int d0 = 0; d0 < 4; ++d0) qf[d0] = *(const bf16x8*)(qp + 16 * d0); }
    const bf16_t* kp = Kb + hb * 64 + lane * 8;
    const bf16_t* vp = VT + hb * 64 + lane * 8;
    f32x16 o0, o1;
#pragma unroll
    for (int r = 0; r < 16; ++r) { o0[r] = 0.f; o1[r] = 0.f; }
    float c = 0.f;
    bf16x8 kf[4], vf[4], kn[4], vn[4];
#pragma unroll
    for (int i = 0; i < 4; ++i) { kf[i] = *(const bf16x8*)(kp + (size_t)q0 * 64 + 512 * i); vf[i] = *(const bf16x8*)(vp + (size_t)q0 * 64 + 512 * i); }
    int kvn = q0 >= 32 ? q0 - 32 : 0;
#pragma unroll
    for (int i = 0; i < 4; ++i) { kn[i] = *(const bf16x8*)(kp + (size_t)kvn * 64 + 512 * i); vn[i] = *(const bf16x8*)(vp + (size_t)kvn * 64 + 512 * i); }
    sb_tile<true>(kf, vf, qf, o0, o1, c, q - 16 * hi, hi);
    for (int kv0 = q0 - 32; kv0 >= 0; kv0 -= 32) {
#pragma unroll
        for (int i = 0; i < 4; ++i) { kf[i] = kn[i]; vf[i] = vn[i]; }
        kvn = kv0 >= 32 ? kv0 - 32 : 0;
#pragma unroll
        for (int i = 0; i < 4; ++i) { kn[i] = *(const bf16x8*)(kp + (size_t)kvn * 64 + 512 * i); vn[i] = *(const bf16x8*)(vp + (size_t)kvn * 64 + 512 * i); }
        sb_tile<false>(kf, vf, qf, o0, o1, c, 0, hi);
        if (__all(c < -150.1f)) break;
    }
    bf16_t* op = MIX + (rowbase + q0 + q) * 1024 + h * 64 + 4 * hi;
#pragma unroll
    for (int g = 0; g < 4; ++g) {
        u32x2 a, bq;
        a.x = cvt_pk_bf16(o0[4 * g], o0[4 * g + 1]); a.y = cvt_pk_bf16(o0[4 * g + 2], o0[4 * g + 3]);
        bq.x = cvt_pk_bf16(o1[4 * g], o1[4 * g + 1]); bq.y = cvt_pk_bf16(o1[4 * g + 2], o1[4 * g + 3]);
        *(u32x2*)(op + 8 * g) = a; *(u32x2*)(op + 32 + 8 * g) = bq;
    }
}

#ifndef P9_DEPTH
#define P9_DEPTH 4
#endif
constexpr int P9_NCT = 1;
constexpr int P9_SBUF = 16 * P9_NCT * 272;
template <bool RO>
__device__ __forceinline__ void p9_job(LAS unsigned char* lds, const bf16_t* __restrict__ kap, const bf16_t* __restrict__ vbp, const float* __restrict__ dcp, const bf16_t* __restrict__ qap, bf16_t* __restrict__ op, int wave, int c16, int kq) {
    constexpr int PD = P9_DEPTH, NCT = P9_NCT;
    f32x4 S[NCT];
#pragma unroll
    for (int ct = 0; ct < NCT; ++ct) S[ct] = (f32x4){0.f, 0.f, 0.f, 0.f};
    bf16x8 ka[PD][2], vb[PD][NCT][2], qa[PD][4]; f32x4 dc[PD];
#define P9_LOAD(u, cc) do { ka[u][0] = *(const bf16x8*)(kap + (size_t)(cc) * 8192); ka[u][1] = *(const bf16x8*)(kap + (size_t)(cc) * 8192 + 512); \
        _Pragma("unroll") for (int ct = 0; ct < NCT; ++ct) { vb[u][ct][0] = *(const bf16x8*)(vbp + (size_t)(cc) * 16384 + ct * 1024); vb[u][ct][1] = *(const bf16x8*)(vbp + (size_t)(cc) * 16384 + ct * 1024 + 512); } \
        dc[u] = *(const f32x4*)(dcp + (size_t)(cc) * 512); \
        if (RO) { _Pragma("unroll") for (int ks = 0; ks < 4; ++ks) qa[u][ks] = *(const bf16x8*)(qap + (size_t)(cc) * 8192 + 512 * ks); } } while (0)
#pragma unroll
    for (int u = 0; u < PD; ++u) P9_LOAD(u, u);
    for (int c0 = 0; c0 < 128; c0 += PD) {
#pragma unroll
        for (int u = 0; u < PD; ++u) {
            const int c = c0 + u;
            LAS unsigned char* sl = lds + (u & 1) * P9_SBUF;
#pragma unroll
            for (int ct = 0; ct < NCT; ++ct) {
                S[ct] = S[ct] * dc[u];
                S[ct] = __builtin_amdgcn_mfma_f32_16x16x32_bf16(ka[u][0], vb[u][ct][0], S[ct], 0, 0, 0);
                S[ct] = __builtin_amdgcn_mfma_f32_16x16x32_bf16(ka[u][1], vb[u][ct][1], S[ct], 0, 0, 0);
            }
#pragma unroll
            for (int ct = 0; ct < NCT; ++ct) { u32x2 wv; wv.x = cvt_pk_bf16(S[ct][0], S[ct][1]); wv.y = cvt_pk_bf16(S[ct][2], S[ct][3]);
                *(LAS u32x2*)(sl + (16 * ct + c16) * 272 + (16 * wave + 4 * kq) * 2) = wv; }
            asm volatile("s_waitcnt lgkmcnt(0)" ::: "memory"); __builtin_amdgcn_s_barrier(); asm volatile("" ::: "memory");
            if (RO) {
                bf16_t* o2 = op + (size_t)c * 64 * 1024;
#pragma unroll
                for (int ct = 0; ct < NCT; ++ct) {
                    f32x4 o = (f32x4){0.f, 0.f, 0.f, 0.f};
#pragma unroll
                    for (int ks = 0; ks < 4; ++ks) {
                        const bf16x8 sb = *(const LAS bf16x8*)(sl + (16 * ct + c16) * 272 + (32 * ks + 8 * kq) * 2);
                        o = __builtin_amdgcn_mfma_f32_16x16x32_bf16(qa[u][ks], sb, o, 0, 0, 0);
                    }
#pragma unroll
                    for (int i = 0; i < 4; ++i) o2[(size_t)i * 1024 + 16 * ct] = (bf16_t)f2bf(o[i]);
                }
            }
            const int cn = c + PD < 128 ? c + PD : 127;
            P9_LOAD(u, cn);
        }
    }
#undef P9_LOAD
}

__global__ void __launch_bounds__(512, 2) hybrid_fwd(Args args) {
    extern __shared__ __attribute__((aligned(16))) unsigned char lds_raw[];
    LAS unsigned char* lds = (LAS unsigned char*)lds_raw;
#define PH_IDS int tid = threadIdx.x; asm volatile("" : "+v"(tid)); const int lane = tid & 63, wave = __builtin_amdgcn_readfirstlane(tid >> 6); \
    const int G = gridDim.x, blk = blockIdx.x; const int gw = blk * 8 + wave, NGW = G * 8; (void)lane; (void)gw; (void)NGW; (void)G; (void)blk;
#define ws (args.ws)
#define x_in (args.in[0])
#define mix_norm_even (args.in[1])
#define w_in_even (args.in[2])
#define sb_q_gain (args.in[3])
#define sb_k_gain (args.in[4])
#define pool_w (args.in[5])
#define pool_scale (args.in[6])
#define w_out_even (args.in[7])
#define mix_norm_odd (args.in[8])
#define w_in_odd (args.in[9])
#define gla_w_a2 (args.in[10])
#define gla_b_a (args.in[11])
#define gla_o_gain (args.in[12])
#define w_out_odd (args.in[13])
#define ffn_norm (args.in[14])
#define ffn_w_up (args.in[15])
#define ffn_conv_w (args.in[16])
#define ffn_conv_b (args.in[17])
#define ffn_w_down (args.in[18])
#define out (args.out)
#define WinE ((bf16_t*)(ws + WS_WINE))
#define PoolW ((bf16_t*)(ws + WS_POOLW))
#define WoutE ((bf16_t*)(ws + WS_WOUTE))
#define WinO ((bf16_t*)(ws + WS_WINO))
#define WoutO ((bf16_t*)(ws + WS_WOUTO))
#define Wup ((bf16_t*)(ws + WS_WUP))
#define Wdn ((bf16_t*)(ws + WS_WDN))
#define SSQ ((float*)(ws + WS_SSQ))
#define DEC ((float*)(ws + WS_DEC))
#define XB ((bf16_t*)(ws + WS_XB))
#define Qb ((bf16_t*)(ws + WS_Q))
#define Kb ((bf16_t*)(ws + WS_K))
#define VT ((bf16_t*)(ws + WS_VT))
#define XP ((bf16_t*)(ws + WS_XP))
#define Rb ((bf16_t*)(ws + WS_R))
#define MIX ((bf16_t*)(ws + WS_MIX))
#define POOLED ((bf16_t*)(ws + WS_POOLED))
#define KDT ((bf16_t*)(ws + WS_KDT))
#define Ob ((bf16_t*)(ws + WS_O))
#define ACT ((bf16_t*)(ws + WS_ACT))
    constexpr size_t SSQ_STRIDE = (size_t)M * 16;

    const int lo = args.ph_lo, hi = args.ph_hi;
#if MK_SINGLE
    if (threadIdx.x < 16) ((LAS unsigned*)(lds + LDS_BYTES - 64))[threadIdx.x] = 0u;
    __syncthreads();
    if (lo < 0) cg::this_grid().sync();
    const XcdBarrier gbar = xcd_barrier_post((unsigned*)(ws) + 1024, (volatile LAS unsigned*)(lds + LDS_BYTES - 64));
#endif
#ifndef PHMASK
#define PHMASK 0xffff
#endif
#define IN(k) (((PHMASK >> (k)) & 1) && lo <= (k) && (k) < hi)
#if MK_SINGLE
#define SEAM(k) do { if (IN(k) && IN((k) + 1)) { xcd_barrier(gbar); } } while (0)
#else
#define SEAM(k) do { } while (0)
#endif

    if (IN(0)) {
        PH_IDS
        LAS float* scr = (LAS float*)(lds + wave * 16384);
        constexpr int I_INE = 16 * 64, I_OUTE = 16 * 32, I_INO = 16 * 97, I_OUTO = 16 * 32, I_UP = 16 * 176, I_DN = 44 * 32;
        constexpr int NITEMS = I_INE + I_OUTE + I_INO + I_OUTO + 2 * I_UP + 2 * I_DN;
        for (int it = gw; it < NITEMS; it += NGW) {
            int r = it;
            if (r < I_INE) { transpose_item(w_in_even, 1024, 2048, mix_norm_even, WinE, MapHead(), scr, r, lane); continue; } r -= I_INE;
            if (r < I_OUTE) { transpose_item(w_out_even, 1024, 1024, (const float*)nullptr, WoutE, MapId(), scr, r, lane); continue; } r -= I_OUTE;
            if (r < I_INO) { transpose_item(w_in_odd, 1024, 3088, mix_norm_odd, WinO, MapId(), scr, r, lane); continue; } r -= I_INO;
            if (r < I_OUTO) { transpose_item(w_out_odd, 1024, 1024, (const float*)nullptr, WoutO, MapId(), scr, r, lane); continue; } r -= I_OUTO;
            if (r < 2 * I_UP) { const int l = r / I_UP; transpose_item(ffn_w_up + (size_t)l * 1024 * FF2, 1024, FF2, ffn_norm + l * 1024, Wup + (size_t)l * FF2 * 1024, MapFfn(), scr, r % I_UP, lane); continue; } r -= 2 * I_UP;
            { const int l = r / I_DN; transpose_item(ffn_w_down + (size_t)l * FF * 1024, FF, 1024, (const float*)nullptr, Wdn + (size_t)l * 1024 * FF, MapId(), scr, r % I_DN, lane); }
        }
        for (int i = blk * 512 + tid; i < 512 * 256; i += G * 512) {
            const int n = i >> 8, kl = i & 255, g = n >> 7, d = n & 127, c = kl & 127;
            const float v = ((kl >> 7) == (g & 1)) ? pool_w[(size_t)(g * 128 + c) * 128 + d] : 0.f;
            PoolW[pg8::bimg_off(n, kl, 4)] = (bf16_t)f2bf(v);
        }
        for (int m0 = gw * 4; m0 < M; m0 += NGW * 4) {
            f32x4 v[4][4];
#pragma unroll
            for (int r = 0; r < 4; ++r)
#pragma unroll
                for (int j = 0; j < 4; ++j) v[r][j] = ((const f32x4*)(x_in + (size_t)(m0 + r) * DM) + lane)[64 * j];
#pragma unroll
            for (int r = 0; r < 4; ++r) {
                float s = 0.f;
                unsigned long long* o8 = (unsigned long long*)(XB + (size_t)(m0 + r) * DM) + lane;
#pragma unroll
                for (int j = 0; j < 4; ++j) { const f32x4 w = v[r][j]; s += (w[0] * w[0] + w[1] * w[1]) + (w[2] * w[2] + w[3] * w[3]);
                    o8[64 * j] = (unsigned long long)cvt_pk_bf16(w[0], w[1]) | ((unsigned long long)cvt_pk_bf16(w[2], w[3]) << 32); }
                s = wave_sum(s);
                if (lane < 16) SSQ[(size_t)(m0 + r) * 16 + lane] = (lane == 0) ? s : 0.f;
            }
        }
    }
    SEAM(0);
    if (IN(1)) {
        PH_IDS
        pg8::Gemm g{XB, WinE, 1024, 1024, 1024, 0, 128, 8}; pg8::StaticOrder S; S.init(128, 8, G, blk);
        LAS float* rst = (LAS float*)(lds + 139264);
        { pg8::Unit pu; for (int i = 0; S.next(i, pu); ++i) if (tid < 256) rst[i * 256 + tid] = row_rstd(SSQ, pu.pm * 256 + tid);
          if (tid >= 256 && tid < 384) rst[4096 + tid - 256] = (tid < 320) ? sb_q_gain[tid - 256] : sb_k_gain[tid - 320];
          __syncthreads(); }
        EpiIn0 E{rst, sb_q_gain, sb_k_gain, Qb, Kb, VT, XP};
        pg8::gemm_phase<EpiIn0, false>(lds, g, S, E);
    }
    SEAM(1);
    if (IN(2)) {
        PH_IDS
        for (int uidx = gw; uidx < NB * 8 * 256; uidx += NGW) {
            const int qb = uidx & 255, bh = uidx >> 8;
            sb_attn_unit(Qb, Kb, VT, MIX, bh >> 3, bh & 7, qb, lane);
        }
    }
    if (IN(3)) {
        PH_IDS
        pg8::Gemm g{POOLED, PoolW, 512, 256, 256, 256, 128, 2}; pg8::StaticOrder S; S.init(128, 2, G, blk);
        { pg8::Unit pu;
          for (int i = 0; S.next(i, pu); ++i)
            for (int it = tid; it < 256 * 32; it += 512) {
                const int t = pu.pm * 256 + (it >> 5), cg8 = pu.pn * 32 + (it & 31), tl = t & 8191, w = 2 << (cg8 >> 4);
                const bf16_t* xp = XP + (size_t)t * 512 + cg8 * 8;
                float sum[8];
#pragma unroll
                for (int e = 0; e < 8; ++e) sum[e] = 0.f;
                u32x4 x0 = (u32x4){0u, 0u, 0u, 0u};
#pragma unroll
                for (int j = 0; j < 16; ++j) {
                    if (j < w && tl - j >= 0) {
                        const u32x4 v = *(const u32x4*)(xp - (size_t)j * 512);
                        if (j == 0) x0 = v;
#pragma unroll
                        for (int e = 0; e < 4; ++e) { sum[2 * e] += __builtin_bit_cast(float, v[e] << 16); sum[2 * e + 1] += __builtin_bit_cast(float, v[e] & 0xffff0000u); }
                    }
                }
                const float inv = 1.0f / (float)(tl + 1 < w ? tl + 1 : w);
                float p[8];
#pragma unroll
                for (int e = 0; e < 4; ++e) { p[2 * e] = sum[2 * e] * inv - __builtin_bit_cast(float, x0[e] << 16); p[2 * e + 1] = sum[2 * e + 1] * inv - __builtin_bit_cast(float, x0[e] & 0xffff0000u); }
                u32x4 o; o.x = cvt_pk_bf16(p[0], p[1]); o.y = cvt_pk_bf16(p[2], p[3]); o.z = cvt_pk_bf16(p[4], p[5]); o.w = cvt_pk_bf16(p[6], p[7]);
                *(u32x4*)(POOLED + (size_t)t * 512 + cg8 * 8) = o;
            }
          asm volatile("s_waitcnt vmcnt(0)" ::: "memory"); __syncthreads(); }
        EpiPool E{pool_scale, MIX};
        pg8::gemm_phase<EpiPool, false>(lds, g, S, E);
    }
    SEAM(3);
    if (IN(4)) {
        PH_IDS
        pg8::Gemm g{MIX, WoutE, 1024, 1024, 1024, 0, 128, 4}; pg8::StaticOrder S; S.init(128, 4, G, blk);
        EpiRes<false> E{XB, out, SSQ + SSQ_STRIDE};
        pg8::gemm_phase<EpiRes<false>, false>(lds, g, S, E);
    }
    SEAM(4);
    if (IN(5)) {
        PH_IDS
        pg8::Gemm g{XB, Wup, 1024, 1024, 1024, 0, 128, 22}; pg8::StaticOrder S; S.init(128, 22, G, blk);
        LAS float* rst = (LAS float*)(lds + 139264);
        { pg8::Unit pu; for (int i = 0; S.next(i, pu); ++i) if (tid < 256) rst[i * 256 + tid] = row_rstd(SSQ + SSQ_STRIDE, pu.pm * 256 + tid);
          __syncthreads(); }
        EpiFfn2 E{rst, ffn_conv_w, ffn_conv_b, ACT, (float*)(ws + WS_UH), (float*)(ws + WS_UT), (LAS float*)(lds + 131072)};
        pg8::gemm_phase<EpiFfn2, false>(lds, g, S, E);
    }
    SEAM(5);
    if (IN(6)) {
        PH_IDS
        pg8::Gemm g{ACT, Wdn, FF, FF, FF, 0, 128, 4}; pg8::StaticOrder S; S.init(128, 4, G, blk);
        { pg8::Unit pu; for (int i = 0; S.next(i, pu); ++i) ffn_fixup(pu.pm, (const float*)(ws + WS_UH), (const float*)(ws + WS_UT), ffn_conv_w, ffn_conv_b, ACT, tid);
          asm volatile("s_waitcnt vmcnt(0)" ::: "memory"); __syncthreads(); }
        EpiRes<false> E{XB, out, SSQ + 2 * SSQ_STRIDE};
        pg8::gemm_phase<EpiRes<false>, true>(lds, g, S, E);
    }
    SEAM(6);
    if (IN(7)) {
        PH_IDS
        pg8::Gemm g{XB, WinO, 1024, 1024, 1024, 0, 128, 12}; pg8::StaticOrder S; S.init(128, 12, G, blk);
        LAS float* rst = (LAS float*)(lds + 139264);
        { pg8::Unit pu; for (int i = 0; S.next(i, pu); ++i) if (tid < 256) rst[i * 256 + tid] = row_rstd(SSQ + 2 * SSQ_STRIDE, pu.pm * 256 + tid);
          __syncthreads(); }
        EpiIn1 E{rst, Qb, Kb, VT, Rb};
        pg8::gemm_phase<EpiIn1, false>(lds, g, S, E);
    }
    SEAM(7);
    if (IN(8)) {
        PH_IDS
        for (int bc = blk; bc < M / 64; bc += G) {
            const int hd = tid;
            float wa[16];
#pragma unroll
            for (int r = 0; r < 16; ++r) wa[r] = gla_w_a2[r * 512 + hd];
            const float ba = gla_b_a[hd];
            LAS float* cums = (LAS float*)lds + hd; float cum = 0.f;
            unsigned short kraw[64];
#pragma unroll
            for (int s = 0; s < 64; ++s) kraw[s] = Kb[(size_t)(bc * 64 + s) * 512 + hd];
            LAS float* al = (LAS float*)(lds + 131072);
            {
                LAS float* part = (LAS float*)(lds + 135168);
                const int c16 = lane & 15, kq = lane >> 4, rt = wave & 3, kh = wave >> 2;
                const bf16_t* ap = XB + (size_t)(bc * 64 + 16 * rt + c16) * 1024 + kh * 512 + 8 * kq;
                const int kb0 = kh * 512 + 8 * kq;
                f32x4 aacc = (f32x4){0.f, 0.f, 0.f, 0.f};
#pragma unroll 4
                for (int ks = 0; ks < 16; ++ks) aacc = __builtin_amdgcn_mfma_f32_16x16x32_bf16(*(const bf16x8*)(ap + 32 * ks), *(const bf16x8*)(WinO + pg8::bimg_off(3072 + c16, kb0 + 32 * ks, 16)), aacc, 0, 0, 0);
#pragma unroll
                for (int i = 0; i < 4; ++i) part[kh * 1024 + (16 * rt + 4 * kq + i) * 16 + c16] = aacc[i];
                __syncthreads();
                for (int idx = tid; idx < 1024; idx += 512) al[idx] = (part[idx] + part[1024 + idx]) * row_rstd(SSQ + 2 * SSQ_STRIDE, bc * 64 + (idx >> 4));
                __syncthreads();
            }
#pragma unroll 4
            for (int s = 0; s < 64; ++s) {
                const f32x4 a0 = *(const LAS f32x4*)(al + s * 16), a1 = *(const LAS f32x4*)(al + s * 16 + 4), a2 = *(const LAS f32x4*)(al + s * 16 + 8), a3 = *(const LAS f32x4*)(al + s * 16 + 12);
                float gl = ba;
                gl += a0[0] * wa[0] + a0[1] * wa[1] + a0[2] * wa[2] + a0[3] * wa[3];
                gl += a1[0] * wa[4] + a1[1] * wa[5] + a1[2] * wa[6] + a1[3] * wa[7];
                gl += a2[0] * wa[8] + a2[1] * wa[9] + a2[2] * wa[10] + a2[3] * wa[11];
                gl += a3[0] * wa[12] + a3[1] * wa[13] + a3[2] * wa[14] + a3[3] * wa[15];
                const float sp = fmaxf(-gl, 0.f) + LN2 * __builtin_amdgcn_logf(1.0f + __builtin_amdgcn_exp2f(-fabsf(gl) * LOG2E));
                cum -= sp * (1.0f / 16.0f);
                cums[s * 512] = cum;
            }
            DEC[(size_t)bc * 512 + hd] = __builtin_amdgcn_exp2f(cum * LOG2E);
            const int b = bc >> 7, c = bc & 127, h = hd >> 7, dk = hd & 127;
            bf16_t* dst = KDT + ((((size_t)(b * 4 + h) * 128 + c) * 8 + (dk >> 4)) * 128 + (dk & 15)) * 8;
#pragma unroll
            for (int s8 = 0; s8 < 8; ++s8) {
                float kd[8];
#pragma unroll
                for (int j = 0; j < 8; ++j) { const int s = s8 * 8 + j;
                    kd[j] = bf2f(kraw[s]) * __builtin_amdgcn_exp2f((cum - cums[s * 512]) * LOG2E); }
                u32x4 o; o.x = cvt_pk_bf16(kd[0], kd[1]); o.y = cvt_pk_bf16(kd[2], kd[3]); o.z = cvt_pk_bf16(kd[4], kd[5]); o.w = cvt_pk_bf16(kd[6], kd[7]);
                *(u32x4*)(dst + (s8 >> 2) * 512 + (s8 & 3) * 128) = o;
            }
            __syncthreads();
        }
    }
    SEAM(8);
    if (IN(9)) {
        PH_IDS
        for (int jb = blk; jb < 16 * (16 / P9_NCT); jb += G) {
            constexpr int JPB = 16 / P9_NCT;
            const int idx = jb >> 3, bh = 2 * (jb & 7) + idx / JPB, dvs = idx % JPB;
            const int b = bh >> 2, h = bh & 3;
            const int c16 = lane & 15, kq = lane >> 4;
            const bf16_t* kap = KDT + (size_t)(b * 4 + h) * 128 * 8192 + wave * 1024 + lane * 8;
            const bf16_t* vbp = VT + (size_t)(b * 4 + h) * 128 * 16384 + dvs * P9_NCT * 1024 + lane * 8;
            const float* dcp = DEC + (size_t)(b * 128) * 512 + h * 128 + 16 * wave + 4 * kq;
            const bf16_t* qap = Qb + (size_t)(b * 4 + h) * 128 * 8192 + (wave & 3) * 2048 + lane * 8;
            bf16_t* op = Ob + ((size_t)b * SEQ + 16 * (wave & 3) + 4 * kq) * 1024 + h * 256 + dvs * 16 * P9_NCT + c16;
            if (wave < 4) p9_job<true>(lds, kap, vbp, dcp, qap, op, wave, c16, kq);
            else p9_job<false>(lds, kap, vbp, dcp, qap, op, wave, c16, kq);
            __syncthreads();
        }
    }
    SEAM(9);
    if (IN(10)) {
        PH_IDS
        const int sub = lane & 15;
        f32x4 gn[4];
#pragma unroll
        for (int i = 0; i < 4; ++i) gn[i] = *(const f32x4*)(gla_o_gain + sub * 16 + 4 * i);
        u32x4 nv[4];
        { const size_t off0 = (size_t)gw * 1024 + lane * 16;
          nv[0] = *(const u32x4*)(Ob + off0); nv[1] = *(const u32x4*)(Ob + off0 + 8); nv[2] = *(const u32x4*)(Rb + off0); nv[3] = *(const u32x4*)(Rb + off0 + 8); }
        for (int t = gw; t < M; t += NGW) {
            const size_t off = (size_t)t * 1024 + lane * 16;
            const u32x4 ov0 = nv[0], ov1 = nv[1], rv0 = nv[2], rv1 = nv[3];
            { const int tn = t + NGW < M ? t + NGW : t; const size_t offn = (size_t)tn * 1024 + lane * 16;
              nv[0] = *(const u32x4*)(Ob + offn); nv[1] = *(const u32x4*)(Ob + offn + 8); nv[2] = *(const u32x4*)(Rb + offn); nv[3] = *(const u32x4*)(Rb + offn + 8); }
            float o[16], r[16];
#pragma unroll
            for (int i = 0; i < 4; ++i) {
                o[2 * i] = __builtin_bit_cast(float, ov0[i] << 16); o[2 * i + 1] = __builtin_bit_cast(float, ov0[i] & 0xffff0000u);
                o[8 + 2 * i] = __builtin_bit_cast(float, ov1[i] << 16); o[8 + 2 * i + 1] = __builtin_bit_cast(float, ov1[i] & 0xffff0000u);
                r[2 * i] = __builtin_bit_cast(float, rv0[i] << 16); r[2 * i + 1] = __builtin_bit_cast(float, rv0[i] & 0xffff0000u);
                r[8 + 2 * i] = __builtin_bit_cast(float, rv1[i] << 16); r[8 + 2 * i + 1] = __builtin_bit_cast(float, rv1[i] & 0xffff0000u);
            }
            float ss = 0.f;
#pragma unroll
            for (int i = 0; i < 16; ++i) ss += o[i] * o[i];
            ss += __shfl_xor(ss, 1); ss += __shfl_xor(ss, 2); ss += __shfl_xor(ss, 4); ss += __shfl_xor(ss, 8);
            const float rs = rsqrtf(ss * (1.0f / 256.0f) + EPS);
            float y[16];
#pragma unroll
            for (int i = 0; i < 16; ++i) { const float sg = r[i] * __builtin_amdgcn_rcpf(1.0f + __builtin_amdgcn_exp2f(-r[i] * LOG2E)); y[i] = o[i] * rs * gn[i >> 2][i & 3] * sg; }
            u32x4 w0, w1;
#pragma unroll
            for (int i = 0; i < 4; ++i) { w0[i] = cvt_pk_bf16(y[2 * i], y[2 * i + 1]); w1[i] = cvt_pk_bf16(y[8 + 2 * i], y[8 + 2 * i + 1]); }
            *(u32x4*)(MIX + off) = w0; *(u32x4*)(MIX + off + 8) = w1;
        }
    }
    SEAM(10);
    if (IN(11)) {
        PH_IDS
        pg8::Gemm g{MIX, WoutO, 1024, 1024, 1024, 0, 128, 4}; pg8::StaticOrder S; S.init(128, 4, G, blk);
        EpiRes<false> E{XB, out, SSQ + 3 * SSQ_STRIDE};
        pg8::gemm_phase<EpiRes<false>, false>(lds, g, S, E);
    }
    SEAM(11);
    if (IN(12)) {
        PH_IDS
        pg8::Gemm g{XB, Wup + (size_t)FF2 * 1024, 1024, 1024, 1024, 0, 128, 22}; pg8::StaticOrder S; S.init(128, 22, G, blk);
        LAS float* rst = (LAS float*)(lds + 139264);
        { pg8::Unit pu; for (int i = 0; S.next(i, pu); ++i) if (tid < 256) rst[i * 256 + tid] = row_rstd(SSQ + 3 * SSQ_STRIDE, pu.pm * 256 + tid);
          __syncthreads(); }
        EpiFfn2 E{rst, ffn_conv_w + 3 * FF2, ffn_conv_b + FF2, ACT, (float*)(ws + WS_UH), (float*)(ws + WS_UT), (LAS float*)(lds + 131072)};
        pg8::gemm_phase<EpiFfn2, false>(lds, g, S, E);
    }
    SEAM(12);
    if (IN(13)) {
        PH_IDS
        pg8::Gemm g{ACT, Wdn + (size_t)1024 * FF, FF, FF, FF, 0, 128, 4}; pg8::StaticOrder S; S.init(128, 4, G, blk);
        { pg8::Unit pu; for (int i = 0; S.next(i, pu); ++i) ffn_fixup(pu.pm, (const float*)(ws + WS_UH), (const float*)(ws + WS_UT), ffn_conv_w + 3 * FF2, ffn_conv_b + FF2, ACT, tid);
          asm volatile("s_waitcnt vmcnt(0)" ::: "memory"); __syncthreads(); }
        EpiRes<true> E{XB, out, SSQ};
        pg8::gemm_phase<EpiRes<true>, true>(lds, g, S, E);
    }
#undef IN
#undef SEAM
#undef ws
#undef x_in
#undef out
}


extern "C" void kernel_launch(void* const* d_in, const int* in_sizes, int n_in, void* d_out, int out_size, void* d_ws, size_t ws_size, hipStream_t stream) {
    static int grid = 0;
    if (grid == 0) {
        if (n_in != 19 || ws_size < WS_END) { fprintf(stderr, "kernel_launch: unexpected n_in %d / ws %zu\n", n_in, ws_size); grid = -1; return; }
        int dev = 0, cus = 0, per_cu = 0;
        hipGetDevice(&dev);
        hipDeviceGetAttribute(&cus, hipDeviceAttributeMultiprocessorCount, dev);
        if (hipFuncSetAttribute((const void*)hybrid_fwd, hipFuncAttributeMaxDynamicSharedMemorySize, LDS_BYTES) != hipSuccess) { fprintf(stderr, "kernel_launch: hipFuncSetAttribute failed\n"); grid = -1; return; }
        if (hipOccupancyMaxActiveBlocksPerMultiprocessor(&per_cu, (const void*)hybrid_fwd, 512, LDS_BYTES) != hipSuccess || per_cu < 1) { fprintf(stderr, "kernel_launch: occupancy query says %d\n", per_cu); per_cu = 1; }
        (void)hipGetLastError();
        grid = cus;
        if (grid != 256) fprintf(stderr, "kernel_launch: note: %d CUs\n", grid);
    }
    if (grid < 0) return;
    Args a{};
    for (int i = 0; i < 19; ++i) a.in[i] = (const float*)d_in[i];
    a.out = (float*)d_out; a.ws = (unsigned char*)d_ws;
#if MK_SINGLE
    a.ph_lo = 0; a.ph_hi = N_PHASES;
    if (hipMemsetAsync(d_ws, 0, 65536, stream) != hipSuccess) { fprintf(stderr, "kernel_launch: hipMemsetAsync failed\n"); return; }
    void* kargs[] = {&a};
    hipError_t e = hipLaunchCooperativeKernel((const void*)hybrid_fwd, dim3(grid), dim3(512), kargs, LDS_BYTES, stream);
    if (e != hipSuccess) fprintf(stderr, "cooperative launch failed: %s (grid %d)\n", hipGetErrorString(e), grid);
#else
#ifndef MAXPH
#define MAXPH N_PHASES
#endif
    for (int p = 0; p < MAXPH; ++p) {
        a.ph_lo = p; a.ph_hi = p + 1;
        hipLaunchKernelGGL(hybrid_fwd, dim3(grid), dim3(512), LDS_BYTES, stream, a);
    }

#endif
}
```

```cpp
#include <hip/hip_runtime.h>
#include <hip/hip_cooperative_groups.h>
#include <cstdio>
#include <cstdint>
namespace cg = cooperative_groups;

#ifndef MK_SINGLE
#define MK_SINGLE 1
#endif

#define LAS __attribute__((address_space(3)))
typedef unsigned short bf16_t;
typedef short bf16x8 __attribute__((ext_vector_type(8)));
typedef float f32x4 __attribute__((ext_vector_type(4)));
typedef float f32x16 __attribute__((ext_vector_type(16)));
typedef unsigned u32x4 __attribute__((ext_vector_type(4)));
typedef unsigned u32x2 __attribute__((ext_vector_type(2)));

constexpr int DM = 1024, NB = 4, SEQ = 8192, M = NB * SEQ;
constexpr int FF = 2816, FF2 = 5632;
constexpr float EPS = 1e-6f;
constexpr float LOG2E = 1.4426950408889634f, LN2 = 0.6931471805599453f;

typedef float f32x2_t __attribute__((ext_vector_type(2))); typedef __bf16 bf16x2_t __attribute__((ext_vector_type(2)));
__device__ __forceinline__ unsigned cvt_pk_bf16(float lo, float hi) { f32x2_t v = {lo, hi}; bf16x2_t b = __builtin_convertvector(v, bf16x2_t); return __builtin_bit_cast(unsigned, b); }
__device__ __forceinline__ unsigned f2bf(float f) { unsigned u = __builtin_bit_cast(unsigned, f); return (u + 0x7fffu + ((u >> 16) & 1u)) >> 16; }
__device__ __forceinline__ float bf2f(unsigned short h) { return __builtin_bit_cast(float, (unsigned)h << 16); }
__device__ __forceinline__ u32x4 pack8(f32x4 a, f32x4 b) { u32x4 w; w.x = cvt_pk_bf16(a[0], a[1]); w.y = cvt_pk_bf16(a[2], a[3]); w.z = cvt_pk_bf16(b[0], b[1]); w.w = cvt_pk_bf16(b[2], b[3]); return w; }
__device__ __forceinline__ float row_rstd(const float* ssq, int row) {
    const f32x4* p = (const f32x4*)(ssq + (size_t)row * 16);
    const f32x4 a = p[0], b = p[1], c = p[2], d = p[3];
    const float s = ((a[0] + a[1]) + (a[2] + a[3])) + ((b[0] + b[1]) + (b[2] + b[3])) + ((c[0] + c[1]) + (c[2] + c[3])) + ((d[0] + d[1]) + (d[2] + d[3]));
    return rsqrtf(s * (1.0f / 1024.0f) + EPS);
}
template <int CTRL> __device__ __forceinline__ float dpp0(float v) {
    return __builtin_bit_cast(float, __builtin_amdgcn_update_dpp(0, __builtin_bit_cast(int, v), CTRL, 0xf, 0xf, true));
}

namespace pg8 {
constexpr int BM = 256, BK = 64, HALF = 128, HTB = HALF * BK * 2, STAGE_BYTES = 8 * HTB, NXCD = 8, WGM = 4;
__host__ __device__ __forceinline__ int lds_byte(int r, int c) { const int st = (r >> 4) * 2 + (c >> 5), rr = r & 15, cc = c & 31, ob = rr * 64 + cc * 2; return st * 1024 + (ob ^ (((ob >> 9) & 1) << 5)); }
__host__ __device__ __forceinline__ void stage_rc(int b, int& R, int& C) { const int st = b / 1024, sb = b % 1024, swz = sb ^ (((sb >> 9) & 1) << 5); R = (st >> 1) * 16 + swz / 64; C = (st & 1) * 32 + (swz % 64) / 2; }
__host__ __device__ __forceinline__ int perm32(int rho) { const int n = rho >> 4, i = rho & 15; return 8 * (i >> 2) + 4 * n + (i & 3); }

struct Unit { int pm, pn, idx; };
__host__ __device__ __forceinline__ size_t bimg_off(int n, int k, int nkt) {
    const int n2 = n & 127, x = n2 & 31, rho = 16 * ((x >> 2) & 1) + 4 * (x >> 3) + (x & 3), R = (n2 & ~31) + rho;
    return ((size_t)((n >> 8) * nkt + (k >> 6)) * 2 + ((n >> 7) & 1)) * 8192 + (size_t)(lds_byte(R, k & 63) >> 1);
}
__host__ __device__ __forceinline__ size_t aimg_off(int row, int col, int nkt) {
    return ((size_t)((row >> 8) * nkt + (col >> 6)) * 2 + ((row >> 7) & 1)) * 8192 + (size_t)(lds_byte(row & 127, col & 63) >> 1);
}
struct Gemm { const bf16_t* A; const bf16_t* Bt; int lda, ldb, K, a_pn_off, nM, nN; };

struct StaticOrder {
    int nM, nN, nwg, G, c;
    __device__ __forceinline__ void init(int nM_, int nN_, int G_, int c_) { nM = nM_; nN = nN_; nwg = nM * nN; G = G_; c = c_; }
    __device__ __forceinline__ bool next(int i, Unit& u) const {
        const long L = (long)i * G + c; if (L >= nwg) return false;
        int wgid = (int)L; { const int q = nwg / NXCD, r = nwg % NXCD, xcd = wgid % NXCD, off = wgid / NXCD; wgid = (xcd < r ? xcd * (q + 1) : r * (q + 1) + (xcd - r) * q) + off; }
        const int nig = WGM * nN, gid = wgid / nig, fm = gid * WGM, gsz = (nM - fm) < WGM ? (nM - fm) : WGM;
        u.pm = fm + ((wgid % nig) % gsz); u.pn = (wgid % nig) / gsz; u.idx = i; return true;
    }
};

template <class Epi, bool HALO>
__device__ __forceinline__ void gemm_phase(LAS unsigned char* lds, const Gemm g, const StaticOrder& S, const Epi& E) {
    int tid = threadIdx.x; asm volatile("" : "+v"(tid));
    const int wid = __builtin_amdgcn_readfirstlane(tid >> 6), lane = tid & 63, wr = wid >> 2, wc = wid & 3, fr = lane & 15, fq = lane >> 4;
    const int K = g.K, nt = K / BK;
    unsigned voffA[2], voffB[2];
#pragma unroll
    for (int i = 0; i < 2; ++i) { int R, C; stage_rc(tid * 16 + i * 8192, R, C); const int Rb = (R & ~31) + perm32(R & 31);
        (void)Rb; voffA[i] = HALO ? (unsigned)(tid * 16 + i * 8192) : (unsigned)(R * g.lda + C) * 2u; voffB[i] = (unsigned)(tid * 16 + i * 8192); }
    const size_t kstep = HALO ? (size_t)2 * HTB : (size_t)(BK * 2), kstepB = (size_t)2 * HTB;
    const size_t hstepA = HALO ? (size_t)HTB : (size_t)128 * g.lda * 2, hstepB = (size_t)HTB;
    const size_t tstepA = HALO ? (size_t)nt * 2 * HTB : (size_t)256 * g.lda * 2, tstepB = (size_t)nt * 2 * HTB;
    const char* A0 = (const char*)g.A;
    const unsigned ldsw = (unsigned)wid * 1024u;
    const int aoff = lds_byte(wr * 64 + fr, fq * 8), boff = lds_byte(wc * 32 + fr, fq * 8);
#define PG8_SA(b, h) (((b) * 2 + (h)) * HTB)
#define PG8_SB(b, h) ((4 + (b) * 2 + (h)) * HTB)
#define PG8_STAGE(bufoff, gbase, voff) do { _Pragma("unroll") for (int _i = 0; _i < 2; ++_i) \
        __builtin_amdgcn_global_load_lds((const unsigned*)((const char*)(gbase) + (voff)[_i]), (LAS unsigned*)(lds + (bufoff) + ldsw + _i * 8192), 16, 0, 0); } while (0)
#define PG8_LDA(dst, b, h) do { _Pragma("unroll") for (int m = 0; m < 4; ++m) _Pragma("unroll") for (int k = 0; k < 2; ++k) dst[m][k] = *(const LAS bf16x8*)(lds + PG8_SA(b, h) + aoff + m * 2048 + k * 1024); } while (0)
#define PG8_LDB(dst, b, h) do { _Pragma("unroll") for (int n = 0; n < 2; ++n) _Pragma("unroll") for (int k = 0; k < 2; ++k) dst[n][k] = *(const LAS bf16x8*)(lds + PG8_SB(b, h) + boff + n * 2048 + k * 1024); } while (0)
#define PG8_MMA(ai, bj, At, Bt) do { __builtin_amdgcn_s_setprio(1); _Pragma("unroll") for (int m = 0; m < 4; ++m) _Pragma("unroll") for (int n = 0; n < 2; ++n) _Pragma("unroll") for (int k = 0; k < 2; ++k) \
        acc[ai][bj][m][n] = __builtin_amdgcn_mfma_f32_16x16x32_bf16(Bt[n][k], At[m][k], acc[ai][bj][m][n], 0, 0, 0); __builtin_amdgcn_s_setprio(0); } while (0)
#define PG8_WAIT_V(n) asm volatile("s_waitcnt vmcnt(" #n ")" ::: "memory")
#define PG8_WAIT_L(n) asm volatile("s_waitcnt lgkmcnt(" #n ")" ::: "memory")
#define PG8_BAR __builtin_amdgcn_s_barrier()
#define PG8_SCHED __builtin_amdgcn_sched_barrier(0)
    Unit cur, nxt; int ui = 0;
    if (!S.next(0, cur)) return;
    f32x4 acc[2][2][4][2];
#pragma unroll
    for (int a = 0; a < 2; ++a)
#pragma unroll
        for (int b = 0; b < 2; ++b)
#pragma unroll
            for (int m = 0; m < 4; ++m)
#pragma unroll
                for (int n = 0; n < 2; ++n) acc[a][b][m][n] = (f32x4){0.f, 0.f, 0.f, 0.f};
    bf16x8 At[4][2], B0[2][2], B1[2][2];
    const char* cA = A0 + (size_t)cur.pm * tstepA + (size_t)cur.pn * g.a_pn_off * 2; const char* cB = (const char*)g.Bt + (size_t)cur.pn * tstepB;
    PG8_STAGE(PG8_SB(0, 0), cB, voffB); PG8_STAGE(PG8_SB(0, 1), cB + hstepB, voffB); PG8_STAGE(PG8_SA(0, 0), cA, voffA); PG8_STAGE(PG8_SA(0, 1), cA + hstepA, voffA);
    if (wr == 1) PG8_BAR;
    PG8_WAIT_V(2); PG8_BAR;
    PG8_STAGE(PG8_SB(1, 0), cB + kstepB, voffB); PG8_STAGE(PG8_SA(1, 0), cA + kstep, voffA); PG8_STAGE(PG8_SB(1, 1), cB + hstepB + kstepB, voffB);
    PG8_WAIT_V(6); PG8_BAR;
    for (;;) {
        const bool has_next = S.next(ui + 1, nxt);
        const char* nA = has_next ? A0 + (size_t)nxt.pm * tstepA + (size_t)nxt.pn * g.a_pn_off * 2 : cA; const char* nB = has_next ? (const char*)g.Bt + (size_t)nxt.pn * tstepB : cB;
        for (int t = 0; t < nt; t += 2) {
            const bool last = (t == nt - 2);
            const char* a1 = cA + (size_t)(t + 1) * kstep;
            const char* a2 = last ? nA : cA + (size_t)(t + 2) * kstep; const char* b2 = last ? nB : cB + (size_t)(t + 2) * kstepB;
            const char* a3 = a2 + kstep; const char* b3 = b2 + kstepB;
            PG8_LDB(B0, 0, 0); PG8_LDB(B1, 0, 1); PG8_SCHED; PG8_LDA(At, 0, 0); PG8_STAGE(PG8_SA(1, 1), a1 + hstepA, voffA);
            PG8_WAIT_V(8); PG8_WAIT_L(0); PG8_BAR; PG8_MMA(0, 0, At, B0); PG8_MMA(0, 1, At, B1); PG8_BAR; PG8_SCHED;
            PG8_LDA(At, 0, 1); PG8_STAGE(PG8_SB(0, 0), b2, voffB); PG8_STAGE(PG8_SB(0, 1), b2 + hstepB, voffB); PG8_STAGE(PG8_SA(0, 0), a2, voffA);
            PG8_WAIT_V(8); PG8_WAIT_L(0); PG8_BAR; PG8_MMA(1, 0, At, B0); PG8_MMA(1, 1, At, B1); PG8_BAR; PG8_SCHED;
            PG8_LDB(B0, 1, 0); PG8_LDB(B1, 1, 1); PG8_SCHED; PG8_LDA(At, 1, 0); PG8_STAGE(PG8_SA(0, 1), a2 + hstepA, voffA);
            PG8_WAIT_V(8); PG8_WAIT_L(0); PG8_BAR; PG8_MMA(0, 0, At, B0); PG8_MMA(0, 1, At, B1); PG8_BAR; PG8_SCHED;
            PG8_LDA(At, 1, 1); PG8_STAGE(PG8_SB(1, 0), b3, voffB); PG8_STAGE(PG8_SB(1, 1), b3 + hstepB, voffB); PG8_STAGE(PG8_SA(1, 0), a3, voffA);
            PG8_WAIT_V(8); PG8_WAIT_L(0); PG8_BAR; PG8_MMA(1, 0, At, B0); PG8_MMA(1, 1, At, B1); PG8_BAR; PG8_SCHED;
        }
        if (wr == 0) PG8_BAR;
        { int l_ = threadIdx.x, wr_ = wr, wc_ = wc;
          asm volatile("" : "+v"(l_), "+s"(wr_), "+s"(wc_));
          E(acc, cur, wr_, wc_, l_ & 15, (l_ >> 4) & 3); }
        if (!has_next) break;
#pragma unroll
        for (int a = 0; a < 2; ++a)
#pragma unroll
            for (int b = 0; b < 2; ++b)
#pragma unroll
                for (int m = 0; m < 4; ++m)
#pragma unroll
                    for (int n = 0; n < 2; ++n) acc[a][b][m][n] = (f32x4){0.f, 0.f, 0.f, 0.f};
        cur = nxt; cA = nA; cB = nB; ++ui;
        if (wr == 1) PG8_BAR;
    }
    PG8_WAIT_V(0);
    PG8_BAR;
#undef PG8_SA
#undef PG8_SB
#undef PG8_STAGE
#undef PG8_LDA
#undef PG8_LDB
#undef PG8_MMA
#undef PG8_WAIT_V
#undef PG8_WAIT_L
#undef PG8_BAR
#undef PG8_SCHED
}
}
typedef f32x4 AccT[2][2][4][2];

struct EpiIn0 {
    const LAS float* rst; const float* qg; const float* kg; bf16_t* Q; bf16_t* Kb; bf16_t* VT; bf16_t* XP;
    __device__ __forceinline__ void operator()(const AccT& acc, const pg8::Unit& u, int wr, int wc, int fr, int fq) const {
        const int pn = u.pn;
        if (pn < 4) {
            const LAS float* gp = rst + 4096 + (pn < 2 ? 0 : 64);
            f32x4 gv[2][2];
#pragma unroll
            for (int bj = 0; bj < 2; ++bj)
#pragma unroll
                for (int n = 0; n < 2; ++n) gv[bj][n] = *(const LAS f32x4*)(gp + 32 * bj + 8 * fq + 4 * n);
            bf16_t* dst = (pn < 2 ? Q : Kb) + (size_t)((pn & 1) * 4 + wc) * 8192 * 64 + 8 * fq;
            const float sc = (pn < 2) ? 0.125f * LOG2E : 1.0f;
#pragma unroll
            for (int ai = 0; ai < 2; ++ai)
#pragma unroll
                for (int m = 0; m < 4; ++m) {
                    const int row = u.pm * 256 + ai * 128 + wr * 64 + m * 16 + fr;
                    const float rs = rst[u.idx * 256 + ai * 128 + wr * 64 + m * 16 + fr];
                    f32x4 v[2][2]; float ss = 0.f;
#pragma unroll
                    for (int bj = 0; bj < 2; ++bj)
#pragma unroll
                        for (int n = 0; n < 2; ++n) { v[bj][n] = acc[ai][bj][m][n] * rs; const f32x4 x = v[bj][n]; ss += (x[0] * x[0] + x[1] * x[1]) + (x[2] * x[2] + x[3] * x[3]); }
                    ss += __shfl_xor(ss, 16); ss += __shfl_xor(ss, 32);
                    const float r2 = rsqrtf(ss * (1.0f / 64.0f) + EPS) * sc;
#pragma unroll
                    for (int bj = 0; bj < 2; ++bj) {
                        const f32x4 a = v[bj][0] * r2 * gv[bj][0], b = v[bj][1] * r2 * gv[bj][1];
                        if (pn < 2) *(u32x4*)(dst + ((size_t)(row >> 13) * 8 * 8192 + (row & 8191)) * 64 + 32 * bj) = pack8(a, b);
                        else {
                            const int sq = row & 8191, kap_ = sq & 31, rho = (kap_ & 3) + 4 * (kap_ >> 4) + 8 * ((kap_ & 15) >> 2);
                            *(u32x4*)(Kb + ((((size_t)((row >> 13) * 8 + (pn & 1) * 4 + wc) * 256 + (sq >> 5)) * 4 + 2 * bj + (fq >> 1)) * 64 + (fq & 1) * 32 + rho) * 8) = pack8(a, b);
                        }
                    }
                }
        } else if (pn < 6) {
#pragma unroll
            for (int ai = 0; ai < 2; ++ai)
#pragma unroll
                for (int m = 0; m < 4; ++m) {
                    const int row = u.pm * 256 + ai * 128 + wr * 64 + m * 16 + fr;
                    const float rs = rst[u.idx * 256 + ai * 128 + wr * 64 + m * 16 + fr];
                    const int b = row >> 13, s = row & 8191, head = (pn - 4) * 4 + wc;
                    const int kap_ = s & 31;
                    bf16_t* vt = VT + ((((size_t)(b * 8 + head) * 256 + (s >> 5)) * 4 + ((kap_ >> 3) & 1)) * 64 + (kap_ >> 4) * 32 + 8 * fq) * 8 + (kap_ & 7);
#pragma unroll
                    for (int bj = 0; bj < 2; ++bj)
#pragma unroll
                        for (int n = 0; n < 2; ++n)
#pragma unroll
                            for (int e = 0; e < 4; ++e) vt[bj * 1024 + (4 * n + e) * 8] = (bf16_t)f2bf(acc[ai][bj][m][n][e] * rs);
                }
        } else {
            bf16_t* dst = XP + (pn - 6) * 256 + 64 * wc + 8 * fq;
#pragma unroll
            for (int ai = 0; ai < 2; ++ai)
#pragma unroll
                for (int m = 0; m < 4; ++m) {
                    const int row = u.pm * 256 + ai * 128 + wr * 64 + m * 16 + fr;
                    const float rs = rst[u.idx * 256 + ai * 128 + wr * 64 + m * 16 + fr];
#pragma unroll
                    for (int bj = 0; bj < 2; ++bj)
                        *(u32x4*)(dst + (size_t)row * 512 + 32 * bj) = pack8(acc[ai][bj][m][0] * rs, acc[ai][bj][m][1] * rs);
                }
        }
    }
};
struct EpiIn1 {
    const LAS float* rst; bf16_t* Q; bf16_t* Kb; bf16_t* VT; bf16_t* R;
    __device__ __forceinline__ void operator()(const AccT& acc, const pg8::Unit& u, int wr, int wc, int fr, int fq) const {
        const int pn = u.pn;
#pragma unroll
        for (int ai = 0; ai < 2; ++ai)
#pragma unroll
            for (int m = 0; m < 4; ++m) {
                const int row = u.pm * 256 + ai * 128 + wr * 64 + m * 16 + fr;
                const float rs = rst[u.idx * 256 + ai * 128 + wr * 64 + m * 16 + fr];
                if (pn < 4) {
                    const float sc = (pn < 2) ? rs * 0.08838834764831845f : rs;
                    if (pn < 2) {
                        const int sq = row & 8191;
                        bf16_t* dst = Q + (((((size_t)((row >> 13) * 4 + 2 * pn) * 128 + (sq >> 6)) * 4 + ((sq >> 4) & 3)) * 4 + wc) * 64 + fq * 16 + (sq & 15)) * 8;
#pragma unroll
                        for (int bj = 0; bj < 2; ++bj) *(u32x4*)(dst + (size_t)bj * 8192 * 128) = pack8(acc[ai][bj][m][0] * sc, acc[ai][bj][m][1] * sc);
                    } else {
                        bf16_t* dst = Kb + (size_t)row * 512 + (pn & 1) * 256 + 32 * wc + 8 * fq;
#pragma unroll
                        for (int bj = 0; bj < 2; ++bj) *(u32x4*)(dst + 128 * bj) = pack8(acc[ai][bj][m][0] * sc, acc[ai][bj][m][1] * sc);
                    }
                } else if (pn < 8) {
                    const int b = row >> 13, s = row & 8191, h = pn - 4;
                    bf16_t* vt = VT + (((((size_t)(b * 4 + h) * 128 + (s >> 6)) * 16 + 2 * wc + (fq >> 1)) * 2 + ((s >> 5) & 1)) * 64 + ((s >> 3) & 3) * 16 + 8 * (fq & 1)) * 8 + (s & 7);
#pragma unroll
                    for (int bj = 0; bj < 2; ++bj)
#pragma unroll
                        for (int n = 0; n < 2; ++n)
#pragma unroll
                            for (int e = 0; e < 4; ++e) vt[bj * 8192 + (4 * n + e) * 8] = (bf16_t)f2bf(acc[ai][bj][m][n][e] * rs);
                } else {
                    bf16_t* dst = R + (size_t)row * 1024 + (pn - 8) * 256 + 32 * wc + 8 * fq;
#pragma unroll
                    for (int bj = 0; bj < 2; ++bj) *(u32x4*)(dst + 128 * bj) = pack8(acc[ai][bj][m][0] * rs, acc[ai][bj][m][1] * rs);
                }
            }
    }
};
template <bool LAST>
struct EpiRes {
    bf16_t* XB; float* out; float* ssq_out;
    __device__ __forceinline__ void operator()(const AccT& acc, const pg8::Unit& u, int wr, int wc, int fr, int fq) const {
#pragma unroll
        for (int ai = 0; ai < 2; ++ai)
#pragma unroll
            for (int m = 0; m < 4; ++m) {
                const int row = u.pm * 256 + ai * 128 + wr * 64 + m * 16 + fr;
                const size_t off = (size_t)row * 1024 + u.pn * 256 + 32 * wc + 8 * fq;
                float ss = 0.f;
#pragma unroll
                for (int bj = 0; bj < 2; ++bj) {
                    const u32x4 bv = *(const u32x4*)(XB + off + 128 * bj);
                    f32x4 b0, b1;
                    b0[0] = __builtin_bit_cast(float, bv[0] << 16); b0[1] = __builtin_bit_cast(float, bv[0] & 0xffff0000u); b0[2] = __builtin_bit_cast(float, bv[1] << 16); b0[3] = __builtin_bit_cast(float, bv[1] & 0xffff0000u);
                    b1[0] = __builtin_bit_cast(float, bv[2] << 16); b1[1] = __builtin_bit_cast(float, bv[2] & 0xffff0000u); b1[2] = __builtin_bit_cast(float, bv[3] << 16); b1[3] = __builtin_bit_cast(float, bv[3] & 0xffff0000u);
                    const f32x4 o0 = b0 + acc[ai][bj][m][0], o1 = b1 + acc[ai][bj][m][1];
                    if (LAST) { *(f32x4*)(out + off + 128 * bj) = o0; *(f32x4*)(out + off + 128 * bj + 4) = o1; }
                    else {
                        *(u32x4*)(XB + off + 128 * bj) = pack8(o0, o1);
                        ss += ((o0[0] * o0[0] + o0[1] * o0[1]) + (o0[2] * o0[2] + o0[3] * o0[3])) + ((o1[0] * o1[0] + o1[1] * o1[1]) + (o1[2] * o1[2] + o1[3] * o1[3]));
                    }
                }
                if (!LAST) {
                    ss += __shfl_xor(ss, 16); ss += __shfl_xor(ss, 32);
                    if (fq == 0) ssq_out[(size_t)row * 16 + u.pn * 4 + wc] = ss;
                }
            }
    }
};
struct EpiPool {
    const float* scale; bf16_t* MIX;
    __device__ __forceinline__ void operator()(const AccT& acc, const pg8::Unit& u, int wr, int wc, int fr, int fq) const {
        const int col0 = u.pn * 256 + 32 * wc + 8 * fq;
        f32x4 sv[2][2];
#pragma unroll
        for (int bj = 0; bj < 2; ++bj)
#pragma unroll
            for (int n = 0; n < 2; ++n) sv[bj][n] = *(const f32x4*)(scale + col0 + 128 * bj + 4 * n);
#pragma unroll
        for (int ai = 0; ai < 2; ++ai)
#pragma unroll
            for (int m = 0; m < 4; ++m) {
                const int row = u.pm * 256 + ai * 128 + wr * 64 + m * 16 + fr;
#pragma unroll
                for (int bj = 0; bj < 2; ++bj)
                    *(u32x4*)(MIX + (size_t)row * 1024 + 512 + col0 + 128 * bj) = pack8(acc[ai][bj][m][0] * sv[bj][0], acc[ai][bj][m][1] * sv[bj][1]);
            }
    }
};
struct EpiFfn2 {
    const LAS float* rst; const float* cw; const float* cb; bf16_t* ACT; float* UH; float* UT; LAS float* tl;
    __device__ __forceinline__ void operator()(AccT& acc, const pg8::Unit& u, int wr, int wc, int fr, int fq) const {
        const int f0 = u.pn * 128 + 32 * wc + 8 * fq, t0 = u.pm * 256, cl = 32 * wc + 8 * fq;
        const bool bstart = (t0 & 8191) == 0;
        LAS float* wt = tl + 6144;
        const int wt_t = (4 * wr + wc) * 64 + fq * 16 + fr;
        f32x4 wreg = (f32x4){0.f, 0.f, 0.f, 0.f};
        if (wt_t < 256) { const int kind = wt_t >> 6, hf = (wt_t & 63) >> 5, c = ((wt_t & 63) * 4) & 127;
            wreg = *(const f32x4*)((kind < 3 ? cw + kind * FF2 : cb) + hf * FF + u.pn * 128 + c); }
#pragma unroll
        for (int ai = 0; ai < 2; ++ai)
#pragma unroll
            for (int m = 0; m < 4; ++m) {
                const float rs = rst[u.idx * 256 + 128 * ai + 64 * wr + 16 * m + fr];
#pragma unroll
                for (int bj = 0; bj < 2; ++bj)
#pragma unroll
                    for (int n = 0; n < 2; ++n) acc[ai][bj][m][n] = acc[ai][bj][m][n] * rs;
            }
        if (fr >= 14) {
#pragma unroll
            for (int ai = 0; ai < 2; ++ai)
#pragma unroll
                for (int bj = 0; bj < 2; ++bj)
#pragma unroll
                    for (int n = 0; n < 2; ++n) *(LAS f32x4*)(tl + (((2 * ai + wr) * 2 + (fr - 14)) * 256 + 128 * bj + cl + 4 * n)) = acc[ai][bj][3][n];
            if (wr == 1) {
#pragma unroll
                for (int bj = 0; bj < 2; ++bj)
#pragma unroll
                    for (int n = 0; n < 2; ++n) *(f32x4*)(UT + (size_t)(u.pm * 2 + (fr - 14)) * FF2 + bj * FF + f0 + 4 * n) = acc[1][bj][3][n];
            }
        }
        if (wr == 0 && fr < 2) {
#pragma unroll
            for (int bj = 0; bj < 2; ++bj)
#pragma unroll
                for (int n = 0; n < 2; ++n) *(f32x4*)(UH + (size_t)(u.pm * 2 + fr) * FF2 + bj * FF + f0 + 4 * n) = acc[0][bj][0][n];
        }
        if (wt_t < 256) *(LAS f32x4*)(wt + 4 * wt_t) = wreg;
        asm volatile("s_waitcnt lgkmcnt(0)" ::: "memory"); __builtin_amdgcn_s_barrier(); asm volatile("" ::: "memory");
        bf16_t* abase = ACT + (size_t)(u.pm * (FF / 64) + 2 * u.pn + (wc >> 1)) * 16384 + (8 * wr + (wc & 1)) * 512 + (((fr * 64 + 16 * fq) ^ ((fr >> 3) << 5)) >> 1);
#pragma unroll
        for (int n = 0; n < 2; ++n) {
            asm volatile("" ::: "memory");
            f32x4 w0[2], w1[2], w2[2], bb[2];
#pragma unroll
            for (int bj = 0; bj < 2; ++bj) { const LAS float* wp = wt + bj * 128 + cl + 4 * n;
                w0[bj] = *(const LAS f32x4*)(wp); w1[bj] = *(const LAS f32x4*)(wp + 256); w2[bj] = *(const LAS f32x4*)(wp + 512); bb[bj] = *(const LAS f32x4*)(wp + 768); }
#pragma unroll
            for (int ai = 0; ai < 2; ++ai) {
                const int blk = 2 * ai + wr;
                f32x4 e1[2], e2[2];
#pragma unroll
                for (int bj = 0; bj < 2; ++bj) {
                    f32x4 v62 = (f32x4){0.f, 0.f, 0.f, 0.f}, v63 = v62;
                    if (blk > 0) { v62 = *(const LAS f32x4*)(tl + (((blk - 1) * 2 + 0) * 256 + 128 * bj + cl + 4 * n)); v63 = *(const LAS f32x4*)(tl + (((blk - 1) * 2 + 1) * 256 + 128 * bj + cl + 4 * n)); }
                    const f32x4 z = (f32x4){0.f, 0.f, 0.f, 0.f};
                    e1[bj] = (fr == 0) ? v63 : z; e2[bj] = (fr == 0) ? v62 : ((fr == 1) ? v63 : z); }
#pragma unroll
                for (int m = 0; m < 4; ++m) {
                    f32x4 cv[2];
#pragma unroll
                    for (int bj = 0; bj < 2; ++bj)
#pragma unroll
                        for (int e = 0; e < 4; ++e) {
                            const float cur = acc[ai][bj][m][n][e];
                            float p1 = dpp0<0x111>(cur), p2 = dpp0<0x112>(cur);
                            if (m > 0) { const float prv = acc[ai][bj][m - 1][n][e]; p1 += dpp0<0x10F>(prv); p2 += dpp0<0x10E>(prv); }
                            else { p1 += e1[bj][e]; p2 += e2[bj][e]; }
                            cv[bj][e] = bb[bj][e] + w2[bj][e] * cur + w1[bj][e] * p1 + w0[bj][e] * p2;
                        }
                    u32x2 w; float r[4];
#pragma unroll
                    for (int e = 0; e < 4; ++e) { const float a = cv[0][e]; r[e] = a * __builtin_amdgcn_rcpf(1.0f + __builtin_amdgcn_exp2f(-a * LOG2E)) * cv[1][e]; }
                    w.x = cvt_pk_bf16(r[0], r[1]); w.y = cvt_pk_bf16(r[2], r[3]);
                    const bool deferred = (blk == 0) && (m == 0) && (fr < 2) && !bstart;
                    if (!deferred) *(u32x2*)(abase + ai * 8192 + m * 1024 + n * 4) = w;
                }
            }
        }
    }
};
__device__ __forceinline__ void ffn_fixup(int pm, const float* __restrict__ UH, const float* __restrict__ UT, const float* __restrict__ cw, const float* __restrict__ cb, bf16_t* __restrict__ ACT, int tid) {
    if (((pm * 256) & 8191) == 0) return;
    for (int f = tid; f < FF; f += 512) {
        float cva[2], cvg[2];
#pragma unroll
        for (int hg = 0; hg < 2; ++hg) {
            const int ch = hg * FF + f;
            const float h0 = UH[(size_t)(pm * 2 + 0) * FF2 + ch], h1 = UH[(size_t)(pm * 2 + 1) * FF2 + ch];
            const float q2 = UT[(size_t)((pm - 1) * 2 + 0) * FF2 + ch], q1 = UT[(size_t)((pm - 1) * 2 + 1) * FF2 + ch];
            const float w0 = cw[ch], w1 = cw[FF2 + ch], w2 = cw[2 * FF2 + ch], bb = cb[ch];
            const float r0 = bb + w2 * h0 + w1 * q1 + w0 * q2, r1 = bb + w2 * h1 + w1 * h0 + w0 * q1;
            if (hg == 0) { cva[0] = r0; cva[1] = r1; } else { cvg[0] = r0; cvg[1] = r1; }
        }
#pragma unroll
        for (int r = 0; r < 2; ++r) { const float a = cva[r]; const float y = a * __builtin_amdgcn_rcpf(1.0f + __builtin_amdgcn_exp2f(-a * LOG2E)) * cvg[r];
            ACT[pg8::aimg_off(pm * 256 + r, f, FF / 64)] = (bf16_t)f2bf(y); }
    }
}

constexpr size_t MiB = 1u << 20;
constexpr size_t WS_WINE = 2 * MiB, WS_POOLW = 6 * MiB, WS_WOUTE = 7 * MiB, WS_WINO = 9 * MiB, WS_WOUTO = 16 * MiB, WS_WUP = 18 * MiB, WS_WDN = 40 * MiB;
constexpr size_t WS_SSQ = 52 * MiB;
constexpr size_t WS_DEC = 60 * MiB;
constexpr size_t WS_ALOW = 61 * MiB;
constexpr size_t WS_XB = 64 * MiB + 65536;
constexpr size_t WS_P0 = 130 * MiB;
constexpr size_t WS_Q = WS_P0, WS_K = WS_P0 + 32 * MiB, WS_VT = WS_P0 + 64 * MiB;
constexpr size_t WS_XP = WS_P0 + 96 * MiB;
constexpr size_t WS_R = WS_P0 + 128 * MiB;
constexpr size_t WS_MIX = 322 * MiB;
constexpr size_t WS_POOLED = 386 * MiB;
constexpr size_t WS_KDT = 386 * MiB, WS_O = 418 * MiB;
constexpr size_t WS_ACT = 130 * MiB;
constexpr size_t WS_UH = 482 * MiB, WS_UT = 490 * MiB;
constexpr size_t WS_END = 498 * MiB;

struct Args {
    const float* in[19]; float* out; unsigned char* ws; int ph_lo, ph_hi;
};
constexpr int N_PHASES = 14;
constexpr int LDS_BYTES = 163840;

#define XB_TMO      128
#define XB_XCNT(j)  (256  + 64 * (j))
#define XB_XSUB(j)  (1280 + 64 * (j))
#define XB_XGEN(j)  (2304 + 64 * (j))
#define XB_TOP      3328
#define XB_TOPGEN   3392
#define XCD_BAR_WORDS 3456
#define XB_SPIN_CAP (1u << 18)

__device__ __forceinline__ unsigned xb_ld(unsigned* p)              { return __hip_atomic_load(p, __ATOMIC_RELAXED, __HIP_MEMORY_SCOPE_AGENT); }
__device__ __forceinline__ unsigned xb_add(unsigned* p, unsigned v) { return __hip_atomic_fetch_add(p, v, __ATOMIC_RELAXED, __HIP_MEMORY_SCOPE_AGENT); }
__device__ __forceinline__ unsigned xb_xcc_id() { return (unsigned)__builtin_amdgcn_s_getreg((3 << 11) | 20) & 0xFu; }
#define XB_SPIN(cond, bar) do { unsigned _sp = 0; while (cond) { __builtin_amdgcn_s_sleep(1); \
    if ((++_sp & 255u) == 0u) { if (xb_ld(&(bar)[XB_TMO])) break; if (_sp > XB_SPIN_CAP) { atomicAdd(&(bar)[XB_TMO], 1u); break; } } } } while (0)

struct XcdBarrier {
    unsigned* bar; unsigned x;
    volatile LAS unsigned* st;
};

__device__ __forceinline__ XcdBarrier xcd_barrier_post(unsigned* bar, volatile LAS unsigned* st) {
    XcdBarrier b; b.bar = bar; b.x = xb_xcc_id(); b.st = st;
    if (threadIdx.x == 0) (void)xb_add(&bar[XB_XCNT(b.x)], 1u);
    return b;
}
__device__ __forceinline__ void xcd_barrier_complete(unsigned* bar, unsigned x, unsigned& nloc, unsigned& nx) {
    const unsigned G = gridDim.x * gridDim.y * gridDim.z;
    unsigned sum, cnt, mine, sp = 0u;
    for (;;) {
        sum = 0u; cnt = 0u; mine = 0u;
#pragma unroll
        for (unsigned j = 0; j < 16; ++j) { const unsigned c = xb_ld(&bar[XB_XCNT(j)]); sum += c; cnt += (c > 0u) ? 1u : 0u; mine = (j == x) ? c : mine; }
        if (sum == G) break;
        __builtin_amdgcn_s_sleep(1);
        if ((++sp & 255u) == 0u) { if (xb_ld(&bar[XB_TMO])) break; if (sp > XB_SPIN_CAP) { atomicAdd(&bar[XB_TMO], 1u); break; } }
    }
    nloc = mine > 0u ? mine : 1u; nx = cnt > 0u ? cnt : 1u;
}

__device__ __forceinline__ void xcd_barrier(const XcdBarrier& b) {
    asm volatile("s_waitcnt vmcnt(0)" ::: "memory");
    __syncthreads();
    if (threadIdx.x == 0) {
        unsigned* bar = b.bar;
        __builtin_amdgcn_s_waitcnt(0);
        unsigned nloc = b.st[0], nx = b.st[1];
        if (nloc == 0u) { xcd_barrier_complete(bar, b.x, nloc, nx); b.st[0] = nloc; b.st[1] = nx; }
        const unsigned old = xb_add(&bar[XB_XSUB(b.x)], 1u);
        const unsigned gen = old / nloc;
        if (old + 1u == (gen + 1u) * nloc) {
            __builtin_amdgcn_fence(__ATOMIC_RELEASE, "agent");
            asm volatile("s_waitcnt vmcnt(0)" ::: "memory");
            const unsigned og = xb_add(&bar[XB_TOP], 1u);
            const unsigned tg = og / nx;
            if (og + 1u == (tg + 1u) * nx) xb_add(&bar[XB_TOPGEN], 1u);
            else XB_SPIN(xb_ld(&bar[XB_TOPGEN]) == tg, bar);
            __builtin_amdgcn_fence(__ATOMIC_ACQUIRE, "agent");
            xb_add(&bar[XB_XGEN(b.x)], 1u);
            asm volatile("s_waitcnt vmcnt(0)" ::: "memory");
        } else {
            XB_SPIN(xb_ld(&bar[XB_TOPGEN]) == gen, bar);
            __builtin_amdgcn_fence(__ATOMIC_ACQUIRE, "agent");
            asm volatile("s_waitcnt vmcnt(0)" ::: "memory");
        }
    }
    __syncthreads();
}


__device__ __forceinline__ float wave_sum(float v) {
#pragma unroll
    for (int o = 1; o < 64; o <<= 1) v += __shfl_xor(v, o);
    return v;
}
struct MapId { __device__ __forceinline__ int operator()(int n) const { return n; } };
struct MapHead { __device__ __forceinline__ int operator()(int n) const { const int a = n & 255; return (n & ~255) + 128 * ((a & 63) >> 5) + 32 * (a >> 6) + (a & 31); } };
struct MapFfn { __device__ __forceinline__ int operator()(int n) const { const int half = n >= FF ? 1 : 0, f = n - half * FF; return 256 * (f >> 7) + 128 * half + (f & 127); } };

template <class RowMap>
__device__ __forceinline__ void transpose_item(const float* W, int K, int N, const float* gain, bf16_t* WT, RowMap rm, LAS float* scr, int item, int lane) {
    const int nblk = (N + 31) / 32, kb = item / nblk, nb = item % nblk, k0 = 64 * kb, n0 = 32 * nb;
    const int nn = n0 + (lane & 31);
    float tv[32];
#pragma unroll
    for (int i = 0; i < 32; ++i) { const int kk = 2 * i + (lane >> 5); tv[i] = (nn < N) ? W[(size_t)(k0 + kk) * N + nn] : 0.f; }
    if (gain) {
#pragma unroll
        for (int i = 0; i < 32; ++i) tv[i] *= gain[k0 + 2 * i + (lane >> 5)];
    }
#pragma unroll
    for (int i = 0; i < 32; ++i) scr[(2 * i + (lane >> 5)) * 33 + (lane & 31)] = tv[i];
    asm volatile("s_waitcnt lgkmcnt(0)" ::: "memory");
    const int c = lane & 7;
#pragma unroll
    for (int j = 0; j < 4; ++j) { const int nl = (lane >> 3) + 8 * j; const LAS float* s = scr + (8 * c) * 33 + nl;
        u32x4 o; o.x = cvt_pk_bf16(s[0 * 33], s[1 * 33]); o.y = cvt_pk_bf16(s[2 * 33], s[3 * 33]); o.z = cvt_pk_bf16(s[4 * 33], s[5 * 33]); o.w = cvt_pk_bf16(s[6 * 33], s[7 * 33]);
        if (n0 + nl < N) *(u32x4*)(WT + pg8::bimg_off(rm(n0 + nl), k0 + 8 * c, K / 64)) = o; }
    asm volatile("s_waitcnt lgkmcnt(0)" ::: "memory");
}

template <bool DIAG>
__device__ __forceinline__ void sb_tile(const bf16x8 (&kf)[4], const bf16x8 (&vf)[4], const bf16x8 (&qf)[4], f32x16& o0, f32x16& o1, float& c, int rel0, int hi) {
    f32x16 s;
#pragma unroll
    for (int r = 0; r < 16; ++r) s[r] = 0.f;
#pragma unroll
    for (int d0 = 0; d0 < 4; ++d0) s = __builtin_amdgcn_mfma_f32_32x32x16_bf16(kf[d0], qf[d0], s, 0, 0, 0);
    float L[16]; float tot = 0.f;
#pragma unroll
    for (int r = 15; r >= 0; --r) {
        const float z = s[r];
        const float sp = fmaxf(z, 0.f) + __builtin_amdgcn_logf(1.0f + __builtin_amdgcn_exp2f(-fabsf(z)));
        if (DIAG) tot += (r < rel0) ? -sp : 0.f; else tot -= sp;
        L[r] = tot;
    }
    const float tot_o = __shfl_xor(tot, 32);
    const float add = c + (hi == 0 ? tot_o : 0.f);
    float w[16];
#pragma unroll
    for (int r = 0; r < 16; ++r) {
        const float e = __builtin_amdgcn_exp2f(s[r] + L[r] + add);
        w[r] = DIAG ? ((r < rel0) ? e : 0.f) : e;
    }
    c += tot + tot_o;
    u32x4 p0, p1;
    p0.x = cvt_pk_bf16(w[0], w[1]); p0.y = cvt_pk_bf16(w[2], w[3]); p0.z = cvt_pk_bf16(w[4], w[5]); p0.w = cvt_pk_bf16(w[6], w[7]);
    p1.x = cvt_pk_bf16(w[8], w[9]); p1.y = cvt_pk_bf16(w[10], w[11]); p1.z = cvt_pk_bf16(w[12], w[13]); p1.w = cvt_pk_bf16(w[14], w[15]);
    const bf16x8 pf0 = __builtin_bit_cast(bf16x8, p0), pf1 = __builtin_bit_cast(bf16x8, p1);
    o0 = __builtin_amdgcn_mfma_f32_32x32x16_bf16(vf[0], pf0, o0, 0, 0, 0);
    o0 = __builtin_amdgcn_mfma_f32_32x32x16_bf16(vf[1], pf1, o0, 0, 0, 0);
    o1 = __builtin_amdgcn_mfma_f32_32x32x16_bf16(vf[2], pf0, o1, 0, 0, 0);
    o1 = __builtin_amdgcn_mfma_f32_32x32x16_bf16(vf[3], pf1, o1, 0, 0, 0);
}
__device__ __forceinline__ void sb_attn_unit(const bf16_t* __restrict__ Q, const bf16_t* __restrict__ Kb, const bf16_t* __restrict__ VT, bf16_t* __restrict__ MIX, int b, int h, int qb, int lane) {
    const int q = lane & 31, hi = lane >> 5, q0 = qb * 32;
    const size_t rowbase = (size_t)b * SEQ;
    bf16x8 qf[4];
    const size_t hb = (size_t)(b * 8 + h) * 8192;
    { const bf16_t* qp = Q + (hb + q0 + q) * 64 + 8 * hi;
#pragma unroll
      for (int d0 = 0; d0 < 4; ++d0) qf[d0] = *(const bf16x8*)(qp + 16 * d0); }
    const bf16_t* kp = Kb + hb * 64 + lane * 8;
    const bf16_t* vp = VT + hb * 64 + lane * 8;
    f32x16 o0, o1;
#pragma unroll
    for (int r = 0; r < 16; ++r) { o0[r] = 0.f; o1[r] = 0.f; }
    float c = 0.f;
    bf16x8 kf[4], vf[4], kn[4], vn[4];
#pragma unroll
    for (int i = 0; i < 4; ++i) { kf[i] = *(const bf16x8*)(kp + (size_t)q0 * 64 + 512 * i); vf[i] = *(const bf16x8*)(vp + (size_t)q0 * 64 + 512 * i); }
    int kvn = q0 >= 32 ? q0 - 32 : 0;
#pragma unroll
    for (int i = 0; i < 4; ++i) { kn[i] = *(const bf16x8*)(kp + (size_t)kvn * 64 + 512 * i); vn[i] = *(const bf16x8*)(vp + (size_t)kvn * 64 + 512 * i); }
    sb_tile<true>(kf, vf, qf, o0, o1, c, q - 16 * hi, hi);
    for (int kv0 = q0 - 32; kv0 >= 0; kv0 -= 32) {
#pragma unroll
        for (int i = 0; i < 4; ++i) { kf[i] = kn[i]; vf[i] = vn[i]; }
        kvn = kv0 >= 32 ? kv0 - 32 : 0;
#pragma unroll
        for (int i = 0; i < 4; ++i) { kn[i] = *(const bf16x8*)(kp + (size_t)kvn * 64 + 512 * i); vn[i] = *(const bf16x8*)(vp + (size_t)kvn * 64 + 512 * i); }
        sb_tile<false>(kf, vf, qf, o0, o1, c, 0, hi);
        if (__all(c < -150.1f)) break;
    }
    bf16_t* op = MIX + (rowbase + q0 + q) * 1024 + h * 64 + 4 * hi;
#pragma unroll
    for (int g = 0; g < 4; ++g) {
        u32x2 a, bq;
        a.x = cvt_pk_bf16(o0[4 * g], o0[4 * g + 1]); a.y = cvt_pk_bf16(o0[4 * g + 2], o0[4 * g + 3]);
        bq.x = cvt_pk_bf16(o1[4 * g], o1[4 * g + 1]); bq.y = cvt_pk_bf16(o1[4 * g + 2], o1[4 * g + 3]);
        *(u32x2*)(op + 8 * g) = a; *(u32x2*)(op + 32 + 8 * g) = bq;
    }
}

#ifndef P9_DEPTH
#define P9_DEPTH 4
#endif
constexpr int P9_NCT = 1;
constexpr int P9_SBUF = 16 * P9_NCT * 272;
template <bool RO>
__device__ __forceinline__ void p9_job(LAS unsigned char* lds, const bf16_t* __restrict__ kap, const bf16_t* __restrict__ vbp, const float* __restrict__ dcp, const bf16_t* __restrict__ qap, bf16_t* __restrict__ op, int wave, int c16, int kq) {
    constexpr int PD = P9_DEPTH, NCT = P9_NCT;
    f32x4 S[NCT];
#pragma unroll
    for (int ct = 0; ct < NCT; ++ct) S[ct] = (f32x4){0.f, 0.f, 0.f, 0.f};
    bf16x8 ka[PD][2], vb[PD][NCT][2], qa[PD][4]; f32x4 dc[PD];
#define P9_LOAD(u, cc) do { ka[u][0] = *(const bf16x8*)(kap + (size_t)(cc) * 8192); ka[u][1] = *(const bf16x8*)(kap + (size_t)(cc) * 8192 + 512); \
        _Pragma("unroll") for (int ct = 0; ct < NCT; ++ct) { vb[u][ct][0] = *(const bf16x8*)(vbp + (size_t)(cc) * 16384 + ct * 1024); vb[u][ct][1] = *(const bf16x8*)(vbp + (size_t)(cc) * 16384 + ct * 1024 + 512); } \
        dc[u] = *(const f32x4*)(dcp + (size_t)(cc) * 512); \
        if (RO) { _Pragma("unroll") for (int ks = 0; ks < 4; ++ks) qa[u][ks] = *(const bf16x8*)(qap + (size_t)(cc) * 8192 + 512 * ks); } } while (0)
#pragma unroll
    for (int u = 0; u < PD; ++u) P9_LOAD(u, u);
    for (int c0 = 0; c0 < 128; c0 += PD) {
#pragma unroll
        for (int u = 0; u < PD; ++u) {
            const int c = c0 + u;
            LAS unsigned char* sl = lds + (u & 1) * P9_SBUF;
#pragma unroll
            for (int ct = 0; ct < NCT; ++ct) {
                S[ct] = S[ct] * dc[u];
                S[ct] = __builtin_amdgcn_mfma_f32_16x16x32_bf16(ka[u][0], vb[u][ct][0], S[ct], 0, 0, 0);
                S[ct] = __builtin_amdgcn_mfma_f32_16x16x32_bf16(ka[u][1], vb[u][ct][1], S[ct], 0, 0, 0);
            }
#pragma unroll
            for (int ct = 0; ct < NCT; ++ct) { u32x2 wv; wv.x = cvt_pk_bf16(S[ct][0], S[ct][1]); wv.y = cvt_pk_bf16(S[ct][2], S[ct][3]);
                *(LAS u32x2*)(sl + (16 * ct + c16) * 272 + (16 * wave + 4 * kq) * 2) = wv; }
            asm volatile("s_waitcnt lgkmcnt(0)" ::: "memory"); __builtin_amdgcn_s_barrier(); asm volatile("" ::: "memory");
            if (RO) {
                bf16_t* o2 = op + (size_t)c * 64 * 1024;
#pragma unroll
                for (int ct = 0; ct < NCT; ++ct) {
                    f32x4 o = (f32x4){0.f, 0.f, 0.f, 0.f};
#pragma unroll
                    for (int ks = 0; ks < 4; ++ks) {
                        const bf16x8 sb = *(const LAS bf16x8*)(sl + (16 * ct + c16) * 272 + (32 * ks + 8 * kq) * 2);
                        o = __builtin_amdgcn_mfma_f32_16x16x32_bf16(qa[u][ks], sb, o, 0, 0, 0);
                    }
#pragma unroll
                    for (int i = 0; i < 4; ++i) o2[(size_t)i * 1024 + 16 * ct] = (bf16_t)f2bf(o[i]);
                }
            }
            const int cn = c + PD < 128 ? c + PD : 127;
            P9_LOAD(u, cn);
        }
    }
#undef P9_LOAD
}

__global__ void __launch_bounds__(512, 2) hybrid_fwd(Args args) {
    extern __shared__ __attribute__((aligned(16))) unsigned char lds_raw[];
    LAS unsigned char* lds = (LAS unsigned char*)lds_raw;
#define PH_IDS int tid = threadIdx.x; asm volatile("" : "+v"(tid)); const int lane = tid & 63, wave = __builtin_amdgcn_readfirstlane(tid >> 6); \
    const int G = gridDim.x, blk = blockIdx.x; const int gw = blk * 8 + wave, NGW = G * 8; (void)lane; (void)gw; (void)NGW; (void)G; (void)blk;
#define ws (args.ws)
#define x_in (args.in[0])
#define mix_norm_even (args.in[1])
#define w_in_even (args.in[2])
#define sb_q_gain (args.in[3])
#define sb_k_gain (args.in[4])
#define pool_w (args.in[5])
#define pool_scale (args.in[6])
#define w_out_even (args.in[7])
#define mix_norm_odd (args.in[8])
#define w_in_odd (args.in[9])
#define gla_w_a2 (args.in[10])
#define gla_b_a (args.in[11])
#define gla_o_gain (args.in[12])
#define w_out_odd (args.in[13])
#define ffn_norm (args.in[14])
#define ffn_w_up (args.in[15])
#define ffn_conv_w (args.in[16])
#define ffn_conv_b (args.in[17])
#define ffn_w_down (args.in[18])
#define out (args.out)
#define WinE ((bf16_t*)(ws + WS_WINE))
#define PoolW ((bf16_t*)(ws + WS_POOLW))
#define WoutE ((bf16_t*)(ws + WS_WOUTE))
#define WinO ((bf16_t*)(ws + WS_WINO))
#define WoutO ((bf16_t*)(ws + WS_WOUTO))
#define Wup ((bf16_t*)(ws + WS_WUP))
#define Wdn ((bf16_t*)(ws + WS_WDN))
#define SSQ ((float*)(ws + WS_SSQ))
#define DEC ((float*)(ws + WS_DEC))
#define XB ((bf16_t*)(ws + WS_XB))
#define Qb ((bf16_t*)(ws + WS_Q))
#define Kb ((bf16_t*)(ws + WS_K))
#define VT ((bf16_t*)(ws + WS_VT))
#define XP ((bf16_t*)(ws + WS_XP))
#define Rb ((bf16_t*)(ws + WS_R))
#define MIX ((bf16_t*)(ws + WS_MIX))
#define POOLED ((bf16_t*)(ws + WS_POOLED))
#define KDT ((bf16_t*)(ws + WS_KDT))
#define Ob ((bf16_t*)(ws + WS_O))
#define ACT ((bf16_t*)(ws + WS_ACT))
    constexpr size_t SSQ_STRIDE = (size_t)M * 16;

    const int lo = args.ph_lo, hi = args.ph_hi;
#if MK_SINGLE
    if (threadIdx.x < 16) ((LAS unsigned*)(lds + LDS_BYTES - 64))[threadIdx.x] = 0u;
    __syncthreads();
    if (lo < 0) cg::this_grid().sync();
    const XcdBarrier gbar = xcd_barrier_post((unsigned*)(ws) + 1024, (volatile LAS unsigned*)(lds + LDS_BYTES - 64));
#endif
#ifndef PHMASK
#define PHMASK 0xffff
#endif
#define IN(k) (((PHMASK >> (k)) & 1) && lo <= (k) && (k) < hi)
#if MK_SINGLE
#define SEAM(k) do { if (IN(k) && IN((k) + 1)) { xcd_barrier(gbar); } } while (0)
#else
#define SEAM(k) do { } while (0)
#endif

    if (IN(0)) {
        PH_IDS
        LAS float* scr = (LAS float*)(lds + wave * 16384);
        constexpr int I_INE = 16 * 64, I_OUTE = 16 * 32, I_INO = 16 * 97, I_OUTO = 16 * 32, I_UP = 16 * 176, I_DN = 44 * 32;
        constexpr int NITEMS = I_INE + I_OUTE + I_INO + I_OUTO + 2 * I_UP + 2 * I_DN;
        for (int it = gw; it < NITEMS; it += NGW) {
            int r = it;
            if (r < I_INE) { transpose_item(w_in_even, 1024, 2048, mix_norm_even, WinE, MapHead(), scr, r, lane); continue; } r -= I_INE;
            if (r < I_OUTE) { transpose_item(w_out_even, 1024, 1024, (const float*)nullptr, WoutE, MapId(), scr, r, lane); continue; } r -= I_OUTE;
            if (r < I_INO) { transpose_item(w_in_odd, 1024, 3088, mix_norm_odd, WinO, MapId(), scr, r, lane); continue; } r -= I_INO;
            if (r < I_OUTO) { transpose_item(w_out_odd, 1024, 1024, (const float*)nullptr, WoutO, MapId(), scr, r, lane); continue; } r -= I_OUTO;
            if (r < 2 * I_UP) { const int l = r / I_UP; transpose_item(ffn_w_up + (size_t)l * 1024 * FF2, 1024, FF2, ffn_norm + l * 1024, Wup + (size_t)l * FF2 * 1024, MapFfn(), scr, r % I_UP, lane); continue; } r -= 2 * I_UP;
            { const int l = r / I_DN; transpose_item(ffn_w_down + (size_t)l * FF * 1024, FF, 1024, (const float*)nullptr, Wdn + (size_t)l * 1024 * FF, MapId(), scr, r % I_DN, lane); }
        }
        for (int i = blk * 512 + tid; i < 512 * 256; i += G * 512) {
            const int n = i >> 8, kl = i & 255, g = n >> 7, d = n & 127, c = kl & 127;
            const float v = ((kl >> 7) == (g & 1)) ? pool_w[(size_t)(g * 128 + c) * 128 + d] : 0.f;
            PoolW[pg8::bimg_off(n, kl, 4)] = (bf16_t)f2bf(v);
        }
        for (int m0 = gw * 4; m0 < M; m0 += NGW * 4) {
            f32x4 v[4][4];
#pragma unroll
            for (int r = 0; r < 4; ++r)
#pragma unroll
                for (int j = 0; j < 4; ++j) v[r][j] = ((const f32x4*)(x_in + (size_t)(m0 + r) * DM) + lane)[64 * j];
#pragma unroll
            for (int r = 0; r < 4; ++r) {
                float s = 0.f;
                unsigned long long* o8 = (unsigned long long*)(XB + (size_t)(m0 + r) * DM) + lane;
#pragma unroll
                for (int j = 0; j < 4; ++j) { const f32x4 w = v[r][j]; s += (w[0] * w[0] + w[1] * w[1]) + (w[2] * w[2] + w[3] * w[3]);
                    o8[64 * j] = (unsigned long long)cvt_pk_bf16(w[0], w[1]) | ((unsigned long long)cvt_pk_bf16(w[2], w[3]) << 32); }
                s = wave_sum(s);
                if (lane < 16) SSQ[(size_t)(m0 + r) * 16 + lane] = (lane == 0) ? s : 0.f;
            }
        }
    }
    SEAM(0);
    if (IN(1)) {
        PH_IDS
        pg8::Gemm g{XB, WinE, 1024, 1024, 1024, 0, 128, 8}; pg8::StaticOrder S; S.init(128, 8, G, blk);
        LAS float* rst = (LAS float*)(lds + 139264);
        { pg8::Unit pu; for (int i = 0; S.next(i, pu); ++i) if (tid < 256) rst[i * 256 + tid] = row_rstd(SSQ, pu.pm * 256 + tid);
          if (tid >= 256 && tid < 384) rst[4096 + tid - 256] = (tid < 320) ? sb_q_gain[tid - 256] : sb_k_gain[tid - 320];
          __syncthreads(); }
        EpiIn0 E{rst, sb_q_gain, sb_k_gain, Qb, Kb, VT, XP};
        pg8::gemm_phase<EpiIn0, false>(lds, g, S, E);
    }
    SEAM(1);
    if (IN(2)) {
        PH_IDS
        for (int uidx = gw; uidx < NB * 8 * 256; uidx += NGW) {
            const int qb = uidx & 255, bh = uidx >> 8;
            sb_attn_unit(Qb, Kb, VT, MIX, bh >> 3, bh & 7, qb, lane);
        }
    }
    if (IN(3)) {
        PH_IDS
        pg8::Gemm g{POOLED, PoolW, 512, 256, 256, 256, 128, 2}; pg8::StaticOrder S; S.init(128, 2, G, blk);
        { pg8::Unit pu;
          for (int i = 0; S.next(i, pu); ++i)
            for (int it = tid; it < 256 * 32; it += 512) {
                const int t = pu.pm * 256 + (it >> 5), cg8 = pu.pn * 32 + (it & 31), tl = t & 8191, w = 2 << (cg8 >> 4);
                const bf16_t* xp = XP + (size_t)t * 512 + cg8 * 8;
                float sum[8];
#pragma unroll
                for (int e = 0; e < 8; ++e) sum[e] = 0.f;
                u32x4 x0 = (u32x4){0u, 0u, 0u, 0u};
#pragma unroll
                for (int j = 0; j < 16; ++j) {
                    if (j < w && tl - j >= 0) {
                        const u32x4 v = *(const u32x4*)(xp - (size_t)j * 512);
                        if (j == 0) x0 = v;
#pragma unroll
                        for (int e = 0; e < 4; ++e) { sum[2 * e] += __builtin_bit_cast(float, v[e] << 16); sum[2 * e + 1] += __builtin_bit_cast(float, v[e] & 0xffff0000u); }
                    }
                }
                const float inv = 1.0f / (float)(tl + 1 < w ? tl + 1 : w);
                float p[8];
#pragma unroll
                for (int e = 0; e < 4; ++e) { p[2 * e] = sum[2 * e] * inv - __builtin_bit_cast(float, x0[e] << 16); p[2 * e + 1] = sum[2 * e + 1] * inv - __builtin_bit_cast(float, x0[e] & 0xffff0000u); }
                u32x4 o; o.x = cvt_pk_bf16(p[0], p[1]); o.y = cvt_pk_bf16(p[2], p[3]); o.z = cvt_pk_bf16(p[4], p[5]); o.w = cvt_pk_bf16(p[6], p[7]);
                *(u32x4*)(POOLED + (size_t)t * 512 + cg8 * 8) = o;
            }
          asm volatile("s_waitcnt vmcnt(0)" ::: "memory"); __syncthreads(); }
        EpiPool E{pool_scale, MIX};
        pg8::gemm_phase<EpiPool, false>(lds, g, S, E);
    }
    SEAM(3);
    if (IN(4)) {
        PH_IDS
        pg8::Gemm g{MIX, WoutE, 1024, 1024, 1024, 0, 128, 4}; pg8::StaticOrder S; S.init(128, 4, G, blk);
        EpiRes<false> E{XB, out, SSQ + SSQ_STRIDE};
        pg8::gemm_phase<EpiRes<false>, false>(lds, g, S, E);
    }
    SEAM(4);
    if (IN(5)) {
        PH_IDS
        pg8::Gemm g{XB, Wup, 1024, 1024, 1024, 0, 128, 22}; pg8::StaticOrder S; S.init(128, 22, G, blk);
        LAS float* rst = (LAS float*)(lds + 139264);
        { pg8::Unit pu; for (int i = 0; S.next(i, pu); ++i) if (tid < 256) rst[i * 256 + tid] = row_rstd(SSQ + SSQ_STRIDE, pu.pm * 256 + tid);
          __syncthreads(); }
        EpiFfn2 E{rst, ffn_conv_w, ffn_conv_b, ACT, (float*)(ws + WS_UH), (float*)(ws + WS_UT), (LAS float*)(lds + 131072)};
        pg8::gemm_phase<EpiFfn2, false>(lds, g, S, E);
    }
    SEAM(5);
    if (IN(6)) {
        PH_IDS
        pg8::Gemm g{ACT, Wdn, FF, FF, FF, 0, 128, 4}; pg8::StaticOrder S; S.init(128, 4, G, blk);
        { pg8::Unit pu; for (int i = 0; S.next(i, pu); ++i) ffn_fixup(pu.pm, (const float*)(ws + WS_UH), (const float*)(ws + WS_UT), ffn_conv_w, ffn_conv_b, ACT, tid);
          asm volatile("s_waitcnt vmcnt(0)" ::: "memory"); __syncthreads(); }
        EpiRes<false> E{XB, out, SSQ + 2 * SSQ_STRIDE};
        pg8::gemm_phase<EpiRes<false>, true>(lds, g, S, E);
    }
    SEAM(6);
    if (IN(7)) {
        PH_IDS
        pg8::Gemm g{XB, WinO, 1024, 1024, 1024, 0, 128, 12}; pg8::StaticOrder S; S.init(128, 12, G, blk);
        LAS float* rst = (LAS float*)(lds + 139264);
        { pg8::Unit pu; for (int i = 0; S.next(i, pu); ++i) if (tid < 256) rst[i * 256 + tid] = row_rstd(SSQ + 2 * SSQ_STRIDE, pu.pm * 256 + tid);
          __syncthreads(); }
        EpiIn1 E{rst, Qb, Kb, VT, Rb};
        pg8::gemm_phase<EpiIn1, false>(lds, g, S, E);
    }
    SEAM(7);
    if (IN(8)) {
        PH_IDS
        for (int bc = blk; bc < M / 64; bc += G) {
            const int hd = tid;
            float wa[16];
#pragma unroll
            for (int r = 0; r < 16; ++r) wa[r] = gla_w_a2[r * 512 + hd];
            const float ba = gla_b_a[hd];
            LAS float* cums = (LAS float*)lds + hd; float cum = 0.f;
            unsigned short kraw[64];
#pragma unroll
            for (int s = 0; s < 64; ++s) kraw[s] = Kb[(size_t)(bc * 64 + s) * 512 + hd];
            LAS float* al = (LAS float*)(lds + 131072);
            {
                LAS float* part = (LAS float*)(lds + 135168);
                const int c16 = lane & 15, kq = lane >> 4, rt = wave & 3, kh = wave >> 2;
                const bf16_t* ap = XB + (size_t)(bc * 64 + 16 * rt + c16) * 1024 + kh * 512 + 8 * kq;
                const int kb0 = kh * 512 + 8 * kq;
                f32x4 aacc = (f32x4){0.f, 0.f, 0.f, 0.f};
#pragma unroll 4
                for (int ks = 0; ks < 16; ++ks) aacc = __builtin_amdgcn_mfma_f32_16x16x32_bf16(*(const bf16x8*)(ap + 32 * ks), *(const bf16x8*)(WinO + pg8::bimg_off(3072 + c16, kb0 + 32 * ks, 16)), aacc, 0, 0, 0);
#pragma unroll
                for (int i = 0; i < 4; ++i) part[kh * 1024 + (16 * rt + 4 * kq + i) * 16 + c16] = aacc[i];
                __syncthreads();
                for (int idx = tid; idx < 1024; idx += 512) al[idx] = (part[idx] + part[1024 + idx]) * row_rstd(SSQ + 2 * SSQ_STRIDE, bc * 64 + (idx >> 4));
                __syncthreads();
            }
#pragma unroll 4
            for (int s = 0; s < 64; ++s) {
                const f32x4 a0 = *(const LAS f32x4*)(al + s * 16), a1 = *(const LAS f32x4*)(al + s * 16 + 4), a2 = *(const LAS f32x4*)(al + s * 16 + 8), a3 = *(const LAS f32x4*)(al + s * 16 + 12);
                float gl = ba;
                gl += a0[0] * wa[0] + a0[1] * wa[1] + a0[2] * wa[2] + a0[3] * wa[3];
                gl += a1[0] * wa[4] + a1[1] * wa[5] + a1[2] * wa[6] + a1[3] * wa[7];
                gl += a2[0] * wa[8] + a2[1] * wa[9] + a2[2] * wa[10] + a2[3] * wa[11];
                gl += a3[0] * wa[12] + a3[1] * wa[13] + a3[2] * wa[14] + a3[3] * wa[15];
                const float sp = fmaxf(-gl, 0.f) + LN2 * __builtin_amdgcn_logf(1.0f + __builtin_amdgcn_exp2f(-fabsf(gl) * LOG2E));
                cum -= sp * (1.0f / 16.0f);
                cums[s * 512] = cum;
            }
            DEC[(size_t)bc * 512 + hd] = __builtin_amdgcn_exp2f(cum * LOG2E);
            const int b = bc >> 7, c = bc & 127, h = hd >> 7, dk = hd & 127;
            bf16_t* dst = KDT + ((((size_t)(b * 4 + h) * 128 + c) * 8 + (dk >> 4)) * 128 + (dk & 15)) * 8;
#pragma unroll
            for (int s8 = 0; s8 < 8; ++s8) {
                float kd[8];
#pragma unroll
                for (int j = 0; j < 8; ++j) { const int s = s8 * 8 + j;
                    kd[j] = bf2f(kraw[s]) * __builtin_amdgcn_exp2f((cum - cums[s * 512]) * LOG2E); }
                u32x4 o; o.x = cvt_pk_bf16(kd[0], kd[1]); o.y = cvt_pk_bf16(kd[2], kd[3]); o.z = cvt_pk_bf16(kd[4], kd[5]); o.w = cvt_pk_bf16(kd[6], kd[7]);
                *(u32x4*)(dst + (s8 >> 2) * 512 + (s8 & 3) * 128) = o;
            }
            __syncthreads();
        }
    }
    SEAM(8);
    if (IN(9)) {
        PH_IDS
        for (int jb = blk; jb < 16 * (16 / P9_NCT); jb += G) {
            constexpr int JPB = 16 / P9_NCT;
            const int idx = jb >> 3, bh = 2 * (jb & 7) + idx / JPB, dvs = idx % JPB;
            const int b = bh >> 2, h = bh & 3;
            const int c16 = lane & 15, kq = lane >> 4;
            const bf16_t* kap = KDT + (size_t)(b * 4 + h) * 128 * 8192 + wave * 1024 + lane * 8;
            const bf16_t* vbp = VT + (size_t)(b * 4 + h) * 128 * 16384 + dvs * P9_NCT * 1024 + lane * 8;
            const float* dcp = DEC + (size_t)(b * 128) * 512 + h * 128 + 16 * wave + 4 * kq;
            const bf16_t* qap = Qb + (size_t)(b * 4 + h) * 128 * 8192 + (wave & 3) * 2048 + lane * 8;
            bf16_t* op = Ob + ((size_t)b * SEQ + 16 * (wave & 3) + 4 * kq) * 1024 + h * 256 + dvs * 16 * P9_NCT + c16;
            if (wave < 4) p9_job<true>(lds, kap, vbp, dcp, qap, op, wave, c16, kq);
            else p9_job<false>(lds, kap, vbp, dcp, qap, op, wave, c16, kq);
            __syncthreads();
        }
    }
    SEAM(9);
    if (IN(10)) {
        PH_IDS
        const int sub = lane & 15;
        f32x4 gn[4];
#pragma unroll
        for (int i = 0; i < 4; ++i) gn[i] = *(const f32x4*)(gla_o_gain + sub * 16 + 4 * i);
        u32x4 nv[4];
        { const size_t off0 = (size_t)gw * 1024 + lane * 16;
          nv[0] = *(const u32x4*)(Ob + off0); nv[1] = *(const u32x4*)(Ob + off0 + 8); nv[2] = *(const u32x4*)(Rb + off0); nv[3] = *(const u32x4*)(Rb + off0 + 8); }
        for (int t = gw; t < M; t += NGW) {
            const size_t off = (size_t)t * 1024 + lane * 16;
            const u32x4 ov0 = nv[0], ov1 = nv[1], rv0 = nv[2], rv1 = nv[3];
            { const int tn = t + NGW < M ? t + NGW : t; const size_t offn = (size_t)tn * 1024 + lane * 16;
              nv[0] = *(const u32x4*)(Ob + offn); nv[1] = *(const u32x4*)(Ob + offn + 8); nv[2] = *(const u32x4*)(Rb + offn); nv[3] = *(const u32x4*)(Rb + offn + 8); }
            float o[16], r[16];
#pragma unroll
            for (int i = 0; i < 4; ++i) {
                o[2 * i] = __builtin_bit_cast(float, ov0[i] << 16); o[2 * i + 1] = __builtin_bit_cast(float, ov0[i] & 0xffff0000u);
                o[8 + 2 * i] = __builtin_bit_cast(float, ov1[i] << 16); o[8 + 2 * i + 1] = __builtin_bit_cast(float, ov1[i] & 0xffff0000u);
                r[2 * i] = __builtin_bit_cast(float, rv0[i] << 16); r[2 * i + 1] = __builtin_bit_cast(float, rv0[i] & 0xffff0000u);
                r[8 + 2 * i] = __builtin_bit_cast(float, rv1[i] << 16); r[8 + 2 * i + 1] = __builtin_bit_cast(float, rv1[i] & 0xffff0000u);
            }
            float ss = 0.f;
#pragma unroll
            for (int i = 0; i < 16; ++i) ss += o[i] * o[i];
            ss += __shfl_xor(ss, 1); ss += __shfl_xor(ss, 2); ss += __shfl_xor(ss, 4); ss += __shfl_xor(ss, 8);
            const float rs = rsqrtf(ss * (1.0f / 256.0f) + EPS);
            float y[16];
#pragma unroll
            for (int i = 0; i < 16; ++i) { const float sg = r[i] * __builtin_amdgcn_rcpf(1.0f + __builtin_amdgcn_exp2f(-r[i] * LOG2E)); y[i] = o[i] * rs * gn[i >> 2][i & 3] * sg; }
            u32x4 w0, w1;
#pragma unroll
            for (int i = 0; i < 4; ++i) { w0[i] = cvt_pk_bf16(y[2 * i], y[2 * i + 1]); w1[i] = cvt_pk_bf16(y[8 + 2 * i], y[8 + 2 * i + 1]); }
            *(u32x4*)(MIX + off) = w0; *(u32x4*)(MIX + off + 8) = w1;
        }
    }
    SEAM(10);
    if (IN(11)) {
        PH_IDS
        pg8::Gemm g{MIX, WoutO, 1024, 1024, 1024, 0, 128, 4}; pg8::StaticOrder S; S.init(128, 4, G, blk);
        EpiRes<false> E{XB, out, SSQ + 3 * SSQ_STRIDE};
        pg8::gemm_phase<EpiRes<false>, false>(lds, g, S, E);
    }
    SEAM(11);
    if (IN(12)) {
        PH_IDS
        pg8::Gemm g{XB, Wup + (size_t)FF2 * 1024, 1024, 1024, 1024, 0, 128, 22}; pg8::StaticOrder S; S.init(128, 22, G, blk);
        LAS float* rst = (LAS float*)(lds + 139264);
        { pg8::Unit pu; for (int i = 0; S.next(i, pu); ++i) if (tid < 256) rst[i * 256 + tid] = row_rstd(SSQ + 3 * SSQ_STRIDE, pu.pm * 256 + tid);
          __syncthreads(); }
        EpiFfn2 E{rst, ffn_conv_w + 3 * FF2, ffn_conv_b + FF2, ACT, (float*)(ws + WS_UH), (float*)(ws + WS_UT), (LAS float*)(lds + 131072)};
        pg8::gemm_phase<EpiFfn2, false>(lds, g, S, E);
    }
    SEAM(12);
    if (IN(13)) {
        PH_IDS
        pg8::Gemm g{ACT, Wdn + (size_t)1024 * FF, FF, FF, FF, 0, 128, 4}; pg8::StaticOrder S; S.init(128, 4, G, blk);
        { pg8::Unit pu; for (int i = 0; S.next(i, pu); ++i) ffn_fixup(pu.pm, (const float*)(ws + WS_UH), (const float*)(ws + WS_UT), ffn_conv_w + 3 * FF2, ffn_conv_b + FF2, ACT, tid);
          asm volatile("s_waitcnt vmcnt(0)" ::: "memory"); __syncthreads(); }
        EpiRes<true> E{XB, out, SSQ};
        pg8::gemm_phase<EpiRes<true>, true>(lds, g, S, E);
    }
#undef IN
#undef SEAM
#undef ws
#undef x_in
#undef out
}


extern "C" void kernel_launch(void* const* d_in, const int* in_sizes, int n_in, void* d_out, int out_size, void* d_ws, size_t ws_size, hipStream_t stream) {
    static int grid = 0;
    if (grid == 0) {
        if (n_in != 19 || ws_size < WS_END) { fprintf(stderr, "kernel_launch: unexpected n_in %d / ws %zu\n", n_in, ws_size); grid = -1; return; }
        int dev = 0, cus = 0, per_cu = 0;
        hipGetDevice(&dev);
        hipDeviceGetAttribute(&cus, hipDeviceAttributeMultiprocessorCount, dev);
        if (hipFuncSetAttribute((const void*)hybrid_fwd, hipFuncAttributeMaxDynamicSharedMemorySize, LDS_BYTES) != hipSuccess) { fprintf(stderr, "kernel_launch: hipFuncSetAttribute failed\n"); grid = -1; return; }
        if (hipOccupancyMaxActiveBlocksPerMultiprocessor(&per_cu, (const void*)hybrid_fwd, 512, LDS_BYTES) != hipSuccess || per_cu < 1) { fprintf(stderr, "kernel_launch: occupancy query says %d\n", per_cu); per_cu = 1; }
        (void)hipGetLastError();
        grid = cus;
        if (grid != 256) fprintf(stderr, "kernel_launch: note: %d CUs\n", grid);
    }
    if (grid < 0) return;
    Args a{};
    for (int i = 0; i < 19; ++i) a.in[i] = (const float*)d_in[i];
    a.out = (float*)d_out; a.ws = (unsigned char*)d_ws;
#if MK_SINGLE
    a.ph_lo = 0; a.ph_hi = N_PHASES;
    if (hipMemsetAsync(d_ws, 0, 65536, stream) != hipSuccess) { fprintf(stderr, "kernel_launch: hipMemsetAsync failed\n"); return; }
    void* kargs[] = {&a};
    hipError_t e = hipLaunchCooperativeKernel((const void*)hybrid_fwd, dim3(grid), dim3(512), kargs, LDS_BYTES, stream);
    if (e != hipSuccess) fprintf(stderr, "cooperative launch failed: %s (grid %d)\n", hipGetErrorString(e), grid);
#else
#ifndef MAXPH
#define MAXPH N_PHASES
#endif
    for (int p = 0; p < MAXPH; ++p) {
        a.ph_lo = p; a.ph_hi = p + 1;
        hipLaunchKernelGGL(hybrid_fwd, dim3(grid), dim3(512), LDS_BYTES, stream, a);
    }

#endif
}
```
